# Optimizing an MI355X kernel written in HIP

```python
import math
import jax, jax.numpy as jnp
from jax import lax
import numpy as np

D_MODEL = 1024
BATCH = 4
SEQ = 8192
DEPTH = 1
DEC_BATCH = 8
DEC_SEQ = 8192
PAST_LEN = 128

HEAD_DIM = 64
N_DIFF_HEADS = 4
DIFF_V_DIM = 2 * HEAD_DIM
N_DIL_HEADS = 8
DIL_PATTERNS = ((128, 1), (512, 4), (2048, 16))
D_FF = 4 * D_MODEL
Q_BLOCK = 128
EPS = 1e-5
DIFF_QK_W = N_DIFF_HEADS * 2 * HEAD_DIM
DIFF_V_W = N_DIFF_HEADS * DIFF_V_DIM
DIL_W = N_DIL_HEADS * HEAD_DIM
IN_W = 2 * DIFF_QK_W + DIFF_V_W + 3 * DIL_W
MIX_W = DIFF_V_W + DIL_W

kernel_name = "hymba_diff_dilated_encoder"


def rmsnorm(x, g):
    xf = x.astype(jnp.float32)
    xf = xf * lax.rsqrt(jnp.mean(xf * xf, axis=-1, keepdims=True) + EPS)
    return (xf * g.astype(jnp.float32)).astype(x.dtype)


def alibi_slopes(n):
    return 2.0 ** (-8.0 * jnp.arange(1, n + 1, dtype=jnp.float32) / n)


def diff_attention(q, k, v, lam, slopes):
    B, S, H, _, dh = q.shape
    scale = dh ** -0.5
    nq = S // Q_BLOCK
    qb = q.reshape(B, nq, Q_BLOCK, H, 2, dh).transpose(1, 0, 2, 3, 4, 5)
    q0 = jnp.arange(nq, dtype=jnp.int32) * Q_BLOCK
    pos_k = jnp.arange(S, dtype=jnp.float32)

    def block(args):
        qblk, start = args
        s = jnp.einsum('bqhmd,bkhmd->bhmqk', qblk, k,
                       preferred_element_type=jnp.float32) * scale
        pos_q = (start + jnp.arange(Q_BLOCK, dtype=jnp.int32)).astype(jnp.float32)
        dist = jnp.abs(pos_q[:, None] - pos_k[None, :])
        s = s - slopes[:, None, None, None] * dist
        p = jax.nn.softmax(s, axis=-1)
        w = p[:, :, 0] - lam * p[:, :, 1]
        return jnp.einsum('bhqk,bkhe->bqhe', w.astype(v.dtype), v,
                          preferred_element_type=jnp.float32)

    o = lax.map(block, (qb, q0))
    return o.transpose(1, 0, 2, 3, 4).reshape(B, S, H, v.shape[-1])


def banded_dilated(q, k, v, dilation, radius, slopes):
    B, H, S, dh = q.shape
    d, r = dilation, radius
    L = S // d
    nb = -(-L // r)
    Lp = nb * r
    scale = dh ** -0.5

    def to_sub(t):
        return t.reshape(B, H, L, d, dh).transpose(0, 1, 3, 2, 4)

    qs = jnp.pad(to_sub(q), ((0, 0), (0, 0), (0, 0), (0, Lp - L), (0, 0)))
    pad_kv = ((0, 0), (0, 0), (0, 0), (r, Lp - L + r), (0, 0))
    ks = jnp.pad(to_sub(k), pad_kv).reshape(B, H, d, nb + 2, r, dh)
    vs = jnp.pad(to_sub(v), pad_kv).reshape(B, H, d, nb + 2, r, dh)
    qs = qs.reshape(B, H, d, nb, r, dh)
    kwin = jnp.concatenate([ks[:, :, :, :-2], ks[:, :, :, 1:-1], ks[:, :, :, 2:]], axis=4)
    vwin = jnp.concatenate([vs[:, :, :, :-2], vs[:, :, :, 1:-1], vs[:, :, :, 2:]], axis=4)

    blk = jnp.arange(nb, dtype=jnp.int32)[:, None] * r
    i_idx = blk + jnp.arange(r, dtype=jnp.int32)[None, :]
    j_idx = blk - r + jnp.arange(3 * r, dtype=jnp.int32)[None, :]
    rel = jnp.abs(i_idx[:, :, None] - j_idx[:, None, :])
    valid = (j_idx[:, None, :] >= 0) & (j_idx[:, None, :] < L) & (rel <= r)
    dist = (rel * d).astype(jnp.float32)

    s = jnp.einsum('bhgnqd,bhgnkd->bhgnqk', qs, kwin,
                   preferred_element_type=jnp.float32) * scale
    s = s - slopes[:, None, None, None, None] * dist
    s = jnp.where(valid, s, -jnp.inf)
    m = jnp.max(s, axis=-1, keepdims=True)
    e = jnp.exp(s - m)
    den = jnp.sum(e, axis=-1, keepdims=True)
    p = e / den
    lse = (m + jnp.log(den))[..., 0]
    o = jnp.einsum('bhgnqk,bhgnkd->bhgnqd', p.astype(v.dtype), vwin,
                   preferred_element_type=jnp.float32)
    o = o.reshape(B, H, d, Lp, dh)[:, :, :, :L].transpose(0, 1, 3, 2, 4).reshape(B, H, S, dh)
    lse = lse.reshape(B, H, d, Lp)[:, :, :, :L].transpose(0, 1, 3, 2).reshape(B, H, S)
    return o, lse


def dilated_mixture(q, k, v, slopes):
    B, S, H, dh = q.shape
    qt, kt, vt = (t.transpose(0, 2, 1, 3) for t in (q, k, v))
    outs, lses = [], []
    for window, dil in DIL_PATTERNS:
        o, lse = banded_dilated(qt, kt, vt, dil, window // (2 * dil), slopes)
        outs.append(o)
        lses.append(lse)
    wts = jax.nn.softmax(jnp.stack(lses, axis=0), axis=0)
    out = jnp.sum(wts[..., None] * jnp.stack(outs, axis=0), axis=0)
    return out.transpose(0, 2, 1, 3).reshape(B, S, H * dh)


def encoder_layer(x, g_mix, w_in, lam_qk, g_diff, g_dil, w_out, g_mlp, w_up, w_down, lam_init):
    B, S, _ = x.shape
    h = rmsnorm(x, g_mix)
    proj = h @ w_in
    splits = np.cumsum([DIFF_QK_W, DIFF_QK_W, DIFF_V_W, DIL_W, DIL_W]).tolist()
    qa, ka, va, qb, kb, vb = jnp.split(proj, splits, axis=-1)

    lq = lam_qk.astype(jnp.float32)
    lam = jnp.exp(jnp.dot(lq[0], lq[1])) - jnp.exp(jnp.dot(lq[2], lq[3])) + lam_init
    oa = diff_attention(qa.reshape(B, S, N_DIFF_HEADS, 2, HEAD_DIM),
                        ka.reshape(B, S, N_DIFF_HEADS, 2, HEAD_DIM),
                        va.reshape(B, S, N_DIFF_HEADS, DIFF_V_DIM),
                        lam, alibi_slopes(N_DIFF_HEADS))
    oa = oa * lax.rsqrt(jnp.mean(oa * oa, axis=-1, keepdims=True) + EPS)
    oa = (oa * g_diff.astype(jnp.float32) * (1.0 - lam_init)).reshape(B, S, DIFF_V_W)

    ob = dilated_mixture(qb.reshape(B, S, N_DIL_HEADS, HEAD_DIM),
                         kb.reshape(B, S, N_DIL_HEADS, HEAD_DIM),
                         vb.reshape(B, S, N_DIL_HEADS, HEAD_DIM),
                         alibi_slopes(N_DIL_HEADS))
    ob = rmsnorm(ob, g_dil)

    mix = jnp.concatenate([oa, ob], axis=-1).astype(x.dtype)
    x = x + mix @ w_out
    h = rmsnorm(x, g_mlp)
    x = x + jnp.square(jax.nn.relu(h @ w_up)) @ w_down
    return x


def trunk(x, g_mix, w_in, lam_qk, g_diff, g_dil, w_out, g_mlp, w_up, w_down, g_final):
    for l in range(DEPTH):
        lam_init = 0.8 - 0.6 * math.exp(-0.3 * l)
        x = encoder_layer(x, g_mix[l], w_in[l], lam_qk[l], g_diff[l], g_dil[l],
                          w_out[l], g_mlp[l], w_up[l], w_down[l], lam_init)
    return rmsnorm(x, g_final)


def setup_inputs(seed: int = 0) -> dict:
    key = jax.random.key(seed)
    ks = jax.random.split(key, 12)
    f32 = jnp.float32

    def gain(k, shape):
        return 1.0 + 0.02 * jax.random.normal(k, shape, f32)

    return {
        "x_prompt": jax.random.normal(ks[0], (BATCH, SEQ, D_MODEL), f32),
        "x_sample": jax.random.normal(ks[1], (DEC_BATCH, DEC_SEQ, D_MODEL), f32),
        "g_mix": gain(ks[2], (DEPTH, D_MODEL)),
        "w_in": jax.random.normal(ks[3], (DEPTH, D_MODEL, IN_W), f32) * D_MODEL ** -0.5,
        "lam_qk": 0.1 * jax.random.normal(ks[4], (DEPTH, 4, HEAD_DIM), f32),
        "g_diff": gain(ks[5], (DEPTH, N_DIFF_HEADS, DIFF_V_DIM)),
        "g_dil": gain(ks[6], (DEPTH, DIL_W)),
        "w_out": jax.random.normal(ks[7], (DEPTH, MIX_W, D_MODEL), f32) * MIX_W ** -0.5,
        "g_mlp": gain(ks[8], (DEPTH, D_MODEL)),
        "w_up": jax.random.normal(ks[9], (DEPTH, D_MODEL, D_FF), f32) * D_MODEL ** -0.5,
        "w_down": jax.random.normal(ks[10], (DEPTH, D_FF, D_MODEL), f32) * D_FF ** -0.5,
        "g_final": gain(ks[11], (D_MODEL,)),
    }


def reference(x_prompt, x_sample, g_mix, w_in, lam_qk, g_diff, g_dil, w_out,
              g_mlp, w_up, w_down, g_final):
    y_prompt = trunk(x_prompt, g_mix, w_in, lam_qk, g_diff, g_dil, w_out,
                     g_mlp, w_up, w_down, g_final)
    y_sample = trunk(x_sample, g_mix, w_in, lam_qk, g_diff, g_dil, w_out,
                     g_mlp, w_up, w_down, g_final)
    return (y_prompt, y_sample)
```

```cpp
#include <hip/hip_runtime.h>
#include <hip/hip_cooperative_groups.h>
#include <cstdio>
#include <cstdint>
namespace cg = cooperative_groups;

#ifndef MK_COOP
#define MK_COOP 1
#endif

#define LAS __attribute__((address_space(3)))
typedef unsigned short bf16_t;
typedef short bf16x8 __attribute__((ext_vector_type(8)));
typedef float f32x4 __attribute__((ext_vector_type(4)));
typedef float f32x16 __attribute__((ext_vector_type(16)));
typedef unsigned u32x4 __attribute__((ext_vector_type(4)));
typedef unsigned u32x2 __attribute__((ext_vector_type(2)));

constexpr int SEQ = 8192, NSEQ = 12, MTOK = NSEQ * SEQ, DM = 1024, FF = 4096, NQK = 2048;
constexpr int PROMPT_ROWS = 4 * SEQ;
constexpr float EPS = 1e-5f;
constexpr float LOG2E = 1.4426950408889634f;
constexpr float C2 = 0.125f * LOG2E;

constexpr size_t MiB = 1u << 20;
constexpr size_t WS_WIN = 0, WS_WOUT = 6 * MiB, WS_WUP = 8 * MiB, WS_WDN = 16 * MiB;
constexpr size_t WS_RS1P = 24 * MiB;
constexpr size_t WS_NRM = 25 * MiB + 512 * 1024;
constexpr size_t WS_BAR = 25 * MiB + 768 * 1024;
constexpr size_t WS_PART2 = 26 * MiB;
constexpr size_t WS_PART3 = 32 * MiB;
constexpr size_t WS_XB = 40 * MiB;
constexpr size_t WS_MIX = WS_XB;
constexpr size_t WS_QK = 232 * MiB;
constexpr size_t WS_VT = 616 * MiB;
constexpr size_t WS_VT4 = 808 * MiB;
constexpr size_t WS_VT16 = 904 * MiB;
constexpr size_t WS_U = 40 * MiB;
constexpr size_t WS_X1B = 808 * MiB;
constexpr size_t WS_END = 1000 * MiB;
constexpr size_t DO_OPART = 0, DO_OPART_STRIDE = 96 * MiB, DO_LSE = 288 * MiB, DO_LSE_STRIDE = (size_t)MTOK * 8 * 4;

constexpr int LDS_BYTES = 135168;

__device__ __forceinline__ unsigned f2bf(float f) { unsigned u = __builtin_bit_cast(unsigned, f); return (u + 0x7fffu + ((u >> 16) & 1u)) >> 16; }
typedef float f32x2_t __attribute__((ext_vector_type(2))); typedef __bf16 bf16x2_t __attribute__((ext_vector_type(2)));
__device__ __forceinline__ unsigned cvtpk(float lo, float hi) { f32x2_t v = {lo, hi}; bf16x2_t b = __builtin_convertvector(v, bf16x2_t); return __builtin_bit_cast(unsigned, b); }
__device__ __forceinline__ float bf_lo(unsigned w) { return __builtin_bit_cast(float, w << 16); }
__device__ __forceinline__ float bf_hi(unsigned w) { return __builtin_bit_cast(float, w & 0xffff0000u); }
__device__ __forceinline__ float wave_sum(float v) {
#pragma unroll
    for (int o = 1; o < 64; o <<= 1) v += __shfl_xor(v, o);
    return v;
}
__device__ __forceinline__ void swap32(float& a, float& b) { asm volatile("s_nop 1\n\tv_permlane32_swap_b32 %0, %1\n\ts_nop 1" : "+v"(a), "+v"(b)); }
__device__ __forceinline__ float xmax32(float v) { float a = v, b = v; swap32(a, b); return __builtin_fmaxf(a, b); }
__device__ __forceinline__ float xsum32(float v) { float a = v, b = v; swap32(a, b); return a + b; }

namespace pg8 {
constexpr int BM = 256, BK = 64, HALF = 128, HTB = HALF * BK * 2, STAGE_BYTES = 8 * HTB, NXCD = 8, WGM = 8;
__host__ __device__ __forceinline__ int lds_byte(int r, int c) { const int st = (r >> 4) * 2 + (c >> 5), rr = r & 15, cc = c & 31, ob = rr * 64 + cc * 2; return st * 1024 + (ob ^ (((ob >> 9) & 1) << 5)); }
__host__ __device__ __forceinline__ void stage_rc(int b, int& R, int& C) { const int st = b / 1024, sb = b % 1024, swz = sb ^ (((sb >> 9) & 1) << 5); R = (st >> 1) * 16 + swz / 64; C = (st & 1) * 32 + (swz % 64) / 2; }
__host__ __device__ __forceinline__ int perm32(int rho) { const int n = rho >> 4, i = rho & 15; return 8 * (i >> 2) + 4 * n + (i & 3); }

struct Unit { int pm, pn; };
struct Gemm { const bf16_t* A; const bf16_t* Bt; int M, N, K, blg; };

struct StaticOrder {
    int nM, nN, nwg, G, c;
    __device__ void init(int M, int N, int G_, int c_) { nM = M / BM; nN = N / BM; nwg = nM * nN; G = G_; c = c_; }
    __device__ bool next(int i, Unit& u) const {
        const long L = (long)i * G + c; if (L >= nwg) return false;
        int wgid = (int)L; { const int q = nwg / NXCD, r = nwg % NXCD, xcd = wgid % NXCD, off = wgid / NXCD; wgid = (xcd < r ? xcd * (q + 1) : r * (q + 1) + (xcd - r) * q) + off; }
        const int nig = WGM * nN, gid = wgid / nig, fm = gid * WGM, gsz = (nM - fm) < WGM ? (nM - fm) : WGM;
        u.pm = fm + ((wgid % nig) % gsz); u.pn = (wgid % nig) / gsz; return true;
    }
};
__device__ __forceinline__ const char* b_base(const Gemm& g, int pn) {
    const int n = pn * BM, seq = n >> 13, nl = n & 8191, lg = g.blg;
    const int gi = nl >> (13 - lg), i0 = nl & ((8192 >> lg) - 1);
    const size_t row = (size_t)seq * 8192 + ((size_t)i0 << lg) + gi;
    return (const char*)g.Bt + row * (size_t)g.K * 2;
}

template <class Epi, bool ALIGN_EPI>
__device__ __forceinline__ void gemm_phase(LAS unsigned char* lds, const Gemm g, const StaticOrder& S, const Epi& E) {
    const int tid = threadIdx.x, wid = __builtin_amdgcn_readfirstlane(tid >> 6), lane = tid & 63, wr = wid >> 2, wc = wid & 3, fr = lane & 15, fq = lane >> 4;
    const int K = g.K, nt = K / BK, lg = g.blg;
    unsigned voffA[2], voffB[2];
#pragma unroll
    for (int i = 0; i < 2; ++i) { int R, C; stage_rc(tid * 16 + i * 8192, R, C); const int Rb = (R & ~31) + perm32(R & 31);
        voffA[i] = (unsigned)(R * K + C) * 2u; voffB[i] = (unsigned)(((Rb << lg) * K) + C) * 2u; }
    const size_t kstep = (size_t)(BK * 2);
    const size_t hstepA = (size_t)HALF * K * 2, hstepB = hstepA << lg;
    const size_t tstepA = 2 * hstepA;
    const unsigned ldsw = (unsigned)wid * 1024u;
    const int aoff = lds_byte(wr * 64 + fr, fq * 8), boff = lds_byte(wc * 32 + fr, fq * 8);
#define PG8_SA(b, h) (((b) * 2 + (h)) * HTB)
#define PG8_SB(b, h) ((4 + (b) * 2 + (h)) * HTB)
#define PG8_STAGE(bufoff, gbase, voff) do { _Pragma("unroll") for (int _i = 0; _i < 2; ++_i) \
        __builtin_amdgcn_global_load_lds((const unsigned*)((const char*)(gbase) + (voff)[_i]), (LAS unsigned*)(lds + (bufoff) + ldsw + _i * 8192), 16, 0, 0); } while (0)
#define PG8_LDA(dst, b, h) do { _Pragma("unroll") for (int m = 0; m < 4; ++m) _Pragma("unroll") for (int k = 0; k < 2; ++k) dst[m][k] = *(const LAS bf16x8*)(lds + PG8_SA(b, h) + aoff + m * 2048 + k * 1024); } while (0)
#define PG8_LDB(dst, b, h) do { _Pragma("unroll") for (int n = 0; n < 2; ++n) _Pragma("unroll") for (int k = 0; k < 2; ++k) dst[n][k] = *(const LAS bf16x8*)(lds + PG8_SB(b, h) + boff + n * 2048 + k * 1024); } while (0)
#define PG8_MMA(ai, bj, At, Bt) do { __builtin_amdgcn_s_setprio(1); _Pragma("unroll") for (int m = 0; m < 4; ++m) _Pragma("unroll") for (int n = 0; n < 2; ++n) _Pragma("unroll") for (int k = 0; k < 2; ++k) \
        acc[ai][bj][m][n] = __builtin_amdgcn_mfma_f32_16x16x32_bf16(Bt[n][k], At[m][k], acc[ai][bj][m][n], 0, 0, 0); __builtin_amdgcn_s_setprio(0); } while (0)
#define PG8_WAIT_V(n) asm volatile("s_waitcnt vmcnt(" #n ")" ::: "memory")
#define PG8_WAIT_L(n) asm volatile("s_waitcnt lgkmcnt(" #n ")" ::: "memory")
#define PG8_BAR __builtin_amdgcn_s_barrier()
#define PG8_SCHED __builtin_amdgcn_sched_barrier(0)
    Unit cur, nxt; int ui = 0;
    if (!S.next(0, cur)) return;
    f32x4 acc[2][2][4][2];
#pragma unroll
    for (int a = 0; a < 2; ++a)
#pragma unroll
        for (int b = 0; b < 2; ++b)
#pragma unroll
            for (int m = 0; m < 4; ++m)
#pragma unroll
                for (int n = 0; n < 2; ++n) acc[a][b][m][n] = (f32x4){0.f, 0.f, 0.f, 0.f};
    bf16x8 At[4][2], B0[2][2], B1[2][2];
    const char* cA = (const char*)g.A + (size_t)cur.pm * tstepA; const char* cB = b_base(g, cur.pn);
    PG8_STAGE(PG8_SB(0, 0), cB, voffB); PG8_STAGE(PG8_SB(0, 1), cB + hstepB, voffB); PG8_STAGE(PG8_SA(0, 0), cA, voffA); PG8_STAGE(PG8_SA(0, 1), cA + hstepA, voffA);
    if (wr == 1) PG8_BAR;
    PG8_WAIT_V(2); PG8_BAR;
    PG8_STAGE(PG8_SB(1, 0), cB + kstep, voffB); PG8_STAGE(PG8_SA(1, 0), cA + kstep, voffA); PG8_STAGE(PG8_SB(1, 1), cB + hstepB + kstep, voffB);
    PG8_WAIT_V(6); PG8_BAR;
    for (;;) {
        const bool has_next = S.next(ui + 1, nxt);
        const char* nA = has_next ? (const char*)g.A + (size_t)nxt.pm * tstepA : cA; const char* nB = has_next ? b_base(g, nxt.pn) : cB;
        for (int t = 0; t < nt; t += 2) {
            const bool last = (t == nt - 2);
            const char* a1 = cA + (size_t)(t + 1) * kstep;
            const char* a2 = last ? nA : cA + (size_t)(t + 2) * kstep; const char* b2 = last ? nB : cB + (size_t)(t + 2) * kstep;
            const char* a3 = a2 + kstep; const char* b3 = b2 + kstep;
            PG8_LDB(B0, 0, 0); PG8_LDB(B1, 0, 1); PG8_SCHED; PG8_LDA(At, 0, 0); PG8_STAGE(PG8_SA(1, 1), a1 + hstepA, voffA);
            PG8_WAIT_V(8); PG8_WAIT_L(0); PG8_BAR; PG8_MMA(0, 0, At, B0); PG8_MMA(0, 1, At, B1); PG8_BAR; PG8_SCHED;
            PG8_LDA(At, 0, 1); PG8_STAGE(PG8_SB(0, 0), b2, voffB); PG8_STAGE(PG8_SB(0, 1), b2 + hstepB, voffB); PG8_STAGE(PG8_SA(0, 0), a2, voffA);
            PG8_WAIT_V(8); PG8_WAIT_L(0); PG8_BAR; PG8_MMA(1, 0, At, B0); PG8_MMA(1, 1, At, B1); PG8_BAR; PG8_SCHED;
            PG8_LDB(B0, 1, 0); PG8_LDB(B1, 1, 1); PG8_SCHED; PG8_LDA(At, 1, 0); PG8_STAGE(PG8_SA(0, 1), a2 + hstepA, voffA);
            PG8_WAIT_V(8); PG8_WAIT_L(0); PG8_BAR; PG8_MMA(0, 0, At, B0); PG8_MMA(0, 1, At, B1); PG8_BAR; PG8_SCHED;
            PG8_LDA(At, 1, 1); PG8_STAGE(PG8_SB(1, 0), b3, voffB); PG8_STAGE(PG8_SB(1, 1), b3 + hstepB, voffB); PG8_STAGE(PG8_SA(1, 0), a3, voffA);
            PG8_WAIT_V(8); PG8_WAIT_L(0); PG8_BAR; PG8_MMA(1, 0, At, B0); PG8_MMA(1, 1, At, B1); PG8_BAR; PG8_SCHED;
        }
        if constexpr (ALIGN_EPI) { if (wr == 0) PG8_BAR; }
        E(acc, cur, wr, wc, fr, fq);
        if (!has_next) break;
#pragma unroll
        for (int a = 0; a < 2; ++a)
#pragma unroll
            for (int b = 0; b < 2; ++b)
#pragma unroll
                for (int m = 0; m < 4; ++m)
#pragma unroll
                    for (int n = 0; n < 2; ++n) acc[a][b][m][n] = (f32x4){0.f, 0.f, 0.f, 0.f};
        cur = nxt; cA = nA; cB = nB; ++ui;
        if constexpr (ALIGN_EPI) { if (wr == 1) PG8_BAR; }
    }
    PG8_WAIT_V(0);
    if constexpr (!ALIGN_EPI) { if (wr == 0) PG8_BAR; }
    PG8_BAR;
#undef PG8_SA
#undef PG8_SB
#undef PG8_STAGE
#undef PG8_LDA
#undef PG8_LDB
#undef PG8_MMA
#undef PG8_WAIT_V
#undef PG8_WAIT_L
#undef PG8_BAR
#undef PG8_SCHED
}

__device__ __forceinline__ u32x4 pack8(f32x4 v0, f32x4 v1) { u32x4 w; w.x = cvtpk(v0[0], v0[1]); w.y = cvtpk(v0[2], v0[3]); w.z = cvtpk(v1[0], v1[1]); w.w = cvtpk(v1[2], v1[3]); return w; }

struct EpiQK {
    bf16_t* O; const float* rs1; unsigned* nrm;
    __device__ __forceinline__ void operator()(const f32x4 (&acc)[2][2][4][2], const Unit& u, int wr, int wc, int fr, int fq) const {
        const int row0 = u.pm * BM + wr * 64 + fr, col0 = u.pn * BM + wc * 32 + 8 * fq;
        const float sct = ((u.pn & 2) == 0) ? C2 : 1.0f;
        float mx[2] = {0.f, 0.f};
#pragma unroll
        for (int ai = 0; ai < 2; ++ai)
#pragma unroll
            for (int m = 0; m < 4; ++m) { const int row = row0 + ai * HALF + m * 16; const float sc = rs1[row] * sct; bf16_t* rowp = O + (size_t)row * NQK + col0;
#pragma unroll
                for (int bj = 0; bj < 2; ++bj) { const f32x4 v0 = acc[ai][bj][m][0] * sc, v1 = acc[ai][bj][m][1] * sc; *(u32x4*)(rowp + bj * HALF) = pack8(v0, v1);
                    if (u.pn < 4) { float ss = (v0[0] * v0[0] + v0[1] * v0[1]) + (v0[2] * v0[2] + v0[3] * v0[3]) + (v1[0] * v1[0] + v1[1] * v1[1]) + (v1[2] * v1[2] + v1[3] * v1[3]);
                        ss += __shfl_xor(ss, 16); ss += __shfl_xor(ss, 32); mx[bj] = __builtin_fmaxf(mx[bj], ss); } } }
        if (u.pn < 4) {
#pragma unroll
            for (int bj = 0; bj < 2; ++bj) { float v = mx[bj];
#pragma unroll
                for (int o = 1; o < 16; o <<= 1) v = __builtin_fmaxf(v, __shfl_xor(v, o));
                if (fr == 0 && fq == 0) atomicMax(nrm + ((u.pm * BM) >> 13) * 32 + u.pn * 8 + bj * 4 + wc, __builtin_bit_cast(unsigned, v)); } }
    }
};
struct EpiVT {
    bf16_t* O; const float* rsp; bf16_t* O4; bf16_t* O16;
    __device__ __forceinline__ void operator()(const f32x4 (&acc)[2][2][4][2], const Unit& u, int wr, int wc, int fr, int fq) const {
        const int row0 = u.pm * BM + wr * 64 + fr, col0 = u.pn * BM + wc * 32 + 8 * fq;
        f32x4 sc[2][2];
#pragma unroll
        for (int bj = 0; bj < 2; ++bj) { sc[bj][0] = *(const f32x4*)(rsp + col0 + bj * HALF); sc[bj][1] = *(const f32x4*)(rsp + col0 + bj * HALF + 4); }
        const bool perm = (u.pm >= 2);
#pragma unroll
        for (int ai = 0; ai < 2; ++ai)
#pragma unroll
            for (int m = 0; m < 4; ++m) { const int row = row0 + ai * HALF + m * 16; bf16_t* rowp = O + (size_t)row * MTOK + col0;
#pragma unroll
                for (int bj = 0; bj < 2; ++bj) { const u32x4 w = pack8(acc[ai][bj][m][0] * sc[bj][0], acc[ai][bj][m][1] * sc[bj][1]); *(u32x4*)(rowp + bj * HALF) = w;
                    if (perm) {
                        const int tg = u.pn * BM + wc * 32 + bj * HALF, sq = tg >> 13, tl = tg & 8191;
                        const size_t rb = (size_t)(row - 512) * MTOK + (size_t)sq * 8192;
                        { const unsigned a0 = (w.x & 0xffffu) | (w.z << 16), a1 = (w.x >> 16) | (w.z & 0xffff0000u), a2 = (w.y & 0xffffu) | (w.w << 16), a3 = (w.y >> 16) | (w.w & 0xffff0000u);
                          const bool lo = (fq & 1) == 0;
                          const unsigned s0 = lo ? a2 : a0, s1 = lo ? a3 : a1;
                          const unsigned r0 = __shfl_xor(s0, 16), r1 = __shfl_xor(s1, 16);
                          u32x2* p4 = (u32x2*)(O4 + rb + (tl >> 2) + 4 * (fq >> 1));
                          if (lo) { p4[0] = (u32x2){a0, r0}; p4[512] = (u32x2){a1, r1}; }
                          else    { p4[1024] = (u32x2){r0, a2}; p4[1536] = (u32x2){r1, a3}; } }
                        { const bool lo = (fq & 2) == 0;
                          const unsigned sx = lo ? w.z : w.x, sy = lo ? w.w : w.y;
                          const unsigned rx = __shfl_xor(sx, 32), ry = __shfl_xor(sy, 32);
                          unsigned* p16 = (unsigned*)(O16 + rb + (size_t)(8 * (fq & 1)) * 512 + (tl >> 4));
                          if (lo) { p16[0] = (w.x & 0xffffu) | (rx << 16); p16[256] = (w.x >> 16) | (rx & 0xffff0000u); p16[512] = (w.y & 0xffffu) | (ry << 16); p16[768] = (w.y >> 16) | (ry & 0xffff0000u); }
                          else    { p16[1024] = (rx & 0xffffu) | (w.z << 16); p16[1280] = (rx >> 16) | (w.z & 0xffff0000u); p16[1536] = (ry & 0xffffu) | (w.w << 16); p16[1792] = (ry >> 16) | (w.w & 0xffff0000u); } } } } }
    }
};
template <bool WITH_BF> struct EpiRes {
    const float* xp; const float* xs; float* out; bf16_t* xb; float* part; bool inplace;
    __device__ __forceinline__ void operator()(const f32x4 (&acc)[2][2][4][2], const Unit& u, int wr, int wc, int fr, int fq) const {
        const int row0 = u.pm * BM + wr * 64 + fr, col0 = u.pn * BM + wc * 32 + 8 * fq;
#pragma unroll
        for (int ai = 0; ai < 2; ++ai)
#pragma unroll
            for (int m = 0; m < 4; ++m) { const int row = row0 + ai * HALF + m * 16;
                const float* bp = inplace ? out + (size_t)row * DM : (row < PROMPT_ROWS ? xp + (size_t)row * DM : xs + (size_t)(row - PROMPT_ROWS) * DM);
                float ss = 0.f;
#pragma unroll
                for (int bj = 0; bj < 2; ++bj) { const int c = col0 + bj * HALF;
                    const f32x4 v0 = acc[ai][bj][m][0] + *(const f32x4*)(bp + c), v1 = acc[ai][bj][m][1] + *(const f32x4*)(bp + c + 4);
                    *(f32x4*)(out + (size_t)row * DM + c) = v0; *(f32x4*)(out + (size_t)row * DM + c + 4) = v1;
                    if (WITH_BF) *(u32x4*)(xb + (size_t)row * DM + c) = pack8(v0, v1);
                    ss += (v0[0] * v0[0] + v0[1] * v0[1]) + (v0[2] * v0[2] + v0[3] * v0[3]) + (v1[0] * v1[0] + v1[1] * v1[1]) + (v1[2] * v1[2] + v1[3] * v1[3]); }
                ss += __shfl_xor(ss, 16); ss += __shfl_xor(ss, 32);
                if (fq == 0) part[(size_t)row * 16 + u.pn * 4 + wc] = ss; }
    }
};
template <bool FROM_X> struct EpiResB {
    const float* xp; const float* xs; bf16_t* xb; float* part;
    __device__ __forceinline__ void operator()(const f32x4 (&acc)[2][2][4][2], const Unit& u, int wr, int wc, int fr, int fq) const {
        const int row0 = u.pm * BM + wr * 64 + fr, col0 = u.pn * BM + wc * 32 + 8 * fq;
#pragma unroll
        for (int ai = 0; ai < 2; ++ai)
#pragma unroll
            for (int m = 0; m < 4; ++m) { const int row = row0 + ai * HALF + m * 16;
                const float* bp = (row < PROMPT_ROWS ? xp + (size_t)row * DM : xs + (size_t)(row - PROMPT_ROWS) * DM);
                float ss = 0.f;
#pragma unroll
                for (int bj = 0; bj < 2; ++bj) { const int c = col0 + bj * HALF; bf16_t* dp = xb + (size_t)row * DM + c;
                    f32x4 b0, b1;
                    if (FROM_X) { b0 = *(const f32x4*)(bp + c); b1 = *(const f32x4*)(bp + c + 4); }
                    else { const u32x4 w = *(const u32x4*)dp; b0 = (f32x4){bf_lo(w.x), bf_hi(w.x), bf_lo(w.y), bf_hi(w.y)}; b1 = (f32x4){bf_lo(w.z), bf_hi(w.z), bf_lo(w.w), bf_hi(w.w)}; }
                    const f32x4 v0 = acc[ai][bj][m][0] + b0, v1 = acc[ai][bj][m][1] + b1;
                    *(u32x4*)dp = pack8(v0, v1);
                    ss += (v0[0] * v0[0] + v0[1] * v0[1]) + (v0[2] * v0[2] + v0[3] * v0[3]) + (v1[0] * v1[0] + v1[1] * v1[1]) + (v1[2] * v1[2] + v1[3] * v1[3]); }
                ss += __shfl_xor(ss, 16); ss += __shfl_xor(ss, 32);
                if (fq == 0) part[(size_t)row * 16 + u.pn * 4 + wc] = ss; }
    }
};
struct EpiUp {
    bf16_t* O; const float* part;
    __device__ __forceinline__ void operator()(const f32x4 (&acc)[2][2][4][2], const Unit& u, int wr, int wc, int fr, int fq) const {
        const int row0 = u.pm * BM + wr * 64 + fr, col0 = u.pn * BM + wc * 32 + 8 * fq;
#pragma unroll
        for (int ai = 0; ai < 2; ++ai)
#pragma unroll
            for (int m = 0; m < 4; ++m) { const int row = row0 + ai * HALF + m * 16; const f32x4* pp = (const f32x4*)(part + (size_t)row * 16);
                const f32x4 p0 = pp[0], p1 = pp[1], p2 = pp[2], p3 = pp[3];
                const float sum = ((p0[0] + p0[1]) + (p0[2] + p0[3])) + ((p1[0] + p1[1]) + (p1[2] + p1[3])) + ((p2[0] + p2[1]) + (p2[2] + p2[3])) + ((p3[0] + p3[1]) + (p3[2] + p3[3]));
                const float r2 = 1.0f / (sum * (1.0f / DM) + EPS); bf16_t* rowp = O + (size_t)row * FF + col0;
#pragma unroll
                for (int bj = 0; bj < 2; ++bj) { f32x4 v0 = acc[ai][bj][m][0], v1 = acc[ai][bj][m][1];
#pragma unroll
                    for (int e = 0; e < 4; ++e) { const float a = __builtin_fmaxf(v0[e], 0.f), b = __builtin_fmaxf(v1[e], 0.f); v0[e] = a * a * r2; v1[e] = b * b * r2; }
                    *(u32x4*)(rowp + bj * HALF) = pack8(v0, v1); } }
    }
};
}

__device__ __forceinline__ int pi32(int r) { return (r & 0x13) | ((r & 4) << 1) | ((r & 8) >> 1); }
__device__ __forceinline__ int crow(int r, int h) { return (r & 3) + 8 * (r >> 2) + 4 * h; }
constexpr float THR = 8.0f;
#define KOFF(r) ((float)(((r) & 7) + 16 * ((r) >> 3)))

struct GSrc { const bf16_t* kp; size_t kts; const bf16_t* vp; size_t vds;
    __device__ __forceinline__ bf16x8 k(int t, int d0) const { return *(const bf16x8*)(kp + t * kts + d0 * 16); }
    __device__ __forceinline__ bf16x8 v(int dt, int t, int s) const { return *(const bf16x8*)(vp + dt * vds + 32 * t + 16 * s); } };
struct LSrc { LAS const unsigned char* ka; LAS const unsigned char* va; int ko[4]; int vo[4];
    __device__ __forceinline__ bf16x8 k(int t, int d0) const { return *(LAS const bf16x8*)(ka + 4096 * t + ko[d0]); }
    __device__ __forceinline__ bf16x8 v(int dt, int t, int s) const { return *(LAS const bf16x8*)(va + 4096 * dt + vo[2 * t + s]); } };

template <int NDT> struct RSrc { bf16x8 kf[2][4]; bf16x8 vf[NDT][2][2];
    __device__ __forceinline__ void load(const GSrc& g) {
#pragma unroll
        for (int t = 0; t < 2; ++t)
#pragma unroll
            for (int d0 = 0; d0 < 4; ++d0) kf[t][d0] = g.k(t, d0);
#pragma unroll
        for (int dt = 0; dt < NDT; ++dt)
#pragma unroll
            for (int t = 0; t < 2; ++t)
#pragma unroll
                for (int s = 0; s < 2; ++s) vf[dt][t][s] = g.v(dt, t, s); }
    __device__ __forceinline__ bf16x8 k(int t, int d0) const { return kf[t][d0]; }
    __device__ __forceinline__ bf16x8 v(int dt, int t, int s) const { return vf[dt][t][s]; } };

template <int NDT, bool FIRST, bool MASK, class Src>
__device__ __forceinline__ void attn_tile(f32x16 (&o)[NDT], float& mhat, float& l, const bf16x8 (&qf)[4], const Src& src, float dq, float nslope) {
    f32x16 s0, s1;
#pragma unroll
    for (int r = 0; r < 16; ++r) {
        const float a0 = __builtin_fabsf(dq - KOFF(r)), a1 = __builtin_fabsf(dq - (KOFF(r) + 32.f));
        s0[r] = __builtin_fmaf(nslope, a0, -mhat); s1[r] = __builtin_fmaf(nslope, a1, -mhat);
        if (MASK) { if (a0 > 64.f) s0[r] = -INFINITY; if (a1 > 64.f) s1[r] = -INFINITY; }
    }
#pragma unroll
    for (int d0 = 0; d0 < 4; ++d0) {
        const bf16x8 k0 = src.k(0, d0), k1 = src.k(1, d0);
        s0 = __builtin_amdgcn_mfma_f32_32x32x16_bf16(k0, qf[d0], s0, 0, 0, 0);
        s1 = __builtin_amdgcn_mfma_f32_32x32x16_bf16(k1, qf[d0], s1, 0, 0, 0);
    }
    float rm = __builtin_fmaxf(s0[0], s1[0]);
#pragma unroll
    for (int r = 1; r < 16; ++r) rm = __builtin_fmaxf(rm, __builtin_fmaxf(s0[r], s1[r]));
    rm = xmax32(rm);
    if (FIRST) {
        mhat += rm;
#pragma unroll
        for (int r = 0; r < 16; ++r) { s0[r] -= rm; s1[r] -= rm; }
    } else if (__any(rm > THR)) {
        const float dl = __builtin_fmaxf(rm, 0.f); mhat += dl;
#pragma unroll
        for (int r = 0; r < 16; ++r) { s0[r] -= dl; s1[r] -= dl; }
        const float f = __builtin_amdgcn_exp2f(-dl); l *= f;
#pragma unroll
        for (int dt = 0; dt < NDT; ++dt)
#pragma unroll
            for (int r = 0; r < 16; ++r) o[dt][r] *= f;
    }
    float sa = 0.f, sb = 0.f;
#pragma unroll
    for (int r = 0; r < 16; ++r) { s0[r] = __builtin_amdgcn_exp2f(s0[r]); s1[r] = __builtin_amdgcn_exp2f(s1[r]); sa += s0[r]; sb += s1[r]; }
    l += sa + sb;
#pragma unroll
    for (int t = 0; t < 2; ++t)
#pragma unroll
        for (int s = 0; s < 2; ++s) {
            u32x4 pw;
            if (t == 0) { pw.x = cvtpk(s0[8 * s + 0], s0[8 * s + 1]); pw.y = cvtpk(s0[8 * s + 2], s0[8 * s + 3]); pw.z = cvtpk(s0[8 * s + 4], s0[8 * s + 5]); pw.w = cvtpk(s0[8 * s + 6], s0[8 * s + 7]); }
            else        { pw.x = cvtpk(s1[8 * s + 0], s1[8 * s + 1]); pw.y = cvtpk(s1[8 * s + 2], s1[8 * s + 3]); pw.z = cvtpk(s1[8 * s + 4], s1[8 * s + 5]); pw.w = cvtpk(s1[8 * s + 6], s1[8 * s + 7]); }
            const bf16x8 pb = __builtin_bit_cast(bf16x8, pw);
#pragma unroll
            for (int dt = 0; dt < NDT; ++dt) {
                const bf16x8 vf = src.v(dt, t, s);
                o[dt] = __builtin_amdgcn_mfma_f32_32x32x16_bf16(vf, pb, o[dt], 0, 0, 0);
            }
        }
}

#define RLX_AGENT __ATOMIC_RELAXED, __HIP_MEMORY_SCOPE_AGENT
#define XB_TMO      128
#define XB_XCNT(j)  (256  + 64 * (j))
#define XB_XSUB(j)  (1280 + 64 * (j))
#define XB_XGEN(j)  (2304 + 64 * (j))
#define XB_TOP      3328
#define XB_TOPGEN   3392
#define XCD_BAR_WORDS 3456
#define XB_SPIN_CAP (1u << 18)

__device__ __forceinline__ unsigned xb_ld(unsigned* p)              { return __hip_atomic_load(p, __ATOMIC_RELAXED, __HIP_MEMORY_SCOPE_AGENT); }
__device__ __forceinline__ unsigned xb_add(unsigned* p, unsigned v) { return __hip_atomic_fetch_add(p, v, __ATOMIC_RELAXED, __HIP_MEMORY_SCOPE_AGENT); }
__device__ __forceinline__ unsigned xb_xcc_id() { return (unsigned)__builtin_amdgcn_s_getreg((3 << 11) | 20) & 0xFu; }
#define XB_SPIN(cond, bar) do { unsigned _sp = 0; while (cond) { __builtin_amdgcn_s_sleep(1); \
    if ((++_sp & 255u) == 0u) { if (xb_ld(&(bar)[XB_TMO])) break; if (_sp > XB_SPIN_CAP) { atomicAdd(&(bar)[XB_TMO], 1u); break; } } } } while (0)

struct XcdBarrier {
    unsigned* bar; unsigned x;
    volatile LAS unsigned* st;
};

__device__ __forceinline__ XcdBarrier xcd_barrier_post(unsigned* bar, volatile LAS unsigned* st) {
    XcdBarrier b; b.bar = bar; b.x = xb_xcc_id(); b.st = st;
    if (threadIdx.x == 0) (void)xb_add(&bar[XB_XCNT(b.x)], 1u);
    return b;
}
__device__ __forceinline__ void xcd_barrier_complete(unsigned* bar, unsigned x, unsigned& nloc, unsigned& nx) {
    const unsigned G = gridDim.x * gridDim.y * gridDim.z;
    unsigned sum, cnt, mine, sp = 0u;
    for (;;) {
        sum = 0u; cnt = 0u; mine = 0u;
#pragma unroll
        for (unsigned j = 0; j < 16; ++j) { const unsigned c = xb_ld(&bar[XB_XCNT(j)]); sum += c; cnt += (c > 0u) ? 1u : 0u; mine = (j == x) ? c : mine; }
        if (sum == G) break;
        __builtin_amdgcn_s_sleep(1);
        if ((++sp & 255u) == 0u) { if (xb_ld(&bar[XB_TMO])) break; if (sp > XB_SPIN_CAP) { atomicAdd(&bar[XB_TMO], 1u); break; } }
    }
    nloc = mine > 0u ? mine : 1u; nx = cnt > 0u ? cnt : 1u;
}

__device__ __forceinline__ void xcd_barrier(const XcdBarrier& b) {
    asm volatile("s_waitcnt vmcnt(0)" ::: "memory");
    __syncthreads();
    if (threadIdx.x == 0) {
        unsigned* bar = b.bar;
        __builtin_amdgcn_s_waitcnt(0);
        unsigned nloc = b.st[0], nx = b.st[1];
        if (nloc == 0u) { xcd_barrier_complete(bar, b.x, nloc, nx); b.st[0] = nloc; b.st[1] = nx; }
        const unsigned old = xb_add(&bar[XB_XSUB(b.x)], 1u);
        const unsigned gen = old / nloc;
        if (old + 1u == (gen + 1u) * nloc) {
            __builtin_amdgcn_fence(__ATOMIC_RELEASE, "agent");
            asm volatile("s_waitcnt vmcnt(0)" ::: "memory");
            const unsigned og = xb_add(&bar[XB_TOP], 1u);
            const unsigned tg = og / nx;
            if (og + 1u == (tg + 1u) * nx) xb_add(&bar[XB_TOPGEN], 1u);
            else XB_SPIN(xb_ld(&bar[XB_TOPGEN]) == tg, bar);
            __builtin_amdgcn_fence(__ATOMIC_ACQUIRE, "agent");
            xb_add(&bar[XB_XGEN(b.x)], 1u);
            asm volatile("s_waitcnt vmcnt(0)" ::: "memory");
        } else {
            XB_SPIN(xb_ld(&bar[XB_XGEN(b.x)]) == gen, bar);
            __builtin_amdgcn_fence(__ATOMIC_ACQUIRE, "agent");
            asm volatile("s_waitcnt vmcnt(0)" ::: "memory");
        }
    }
    __syncthreads();
}


struct Args { const float* in[12]; float* out; unsigned char* ws; int ph_lo, ph_hi; };

constexpr int ATT_KSLOT = 16384, ATT_VRING = 49152, ATT_VSLOT = 16384, ATT_QOFF = 98304;
#define ATT_WAITBAR(N) asm volatile("s_waitcnt vmcnt(" #N ") lgkmcnt(0)\n\ts_barrier" ::: "memory")

__device__ __forceinline__ float max3f(float a, float b, float c) { float r; asm("v_max3_f32 %0, %1, %2, %3" : "=v"(r) : "v"(a), "v"(b), "v"(c)); return r; }
__device__ __forceinline__ float max2f(float a, float b) { float r; asm("v_max_f32_e32 %0, %1, %2" : "=v"(r) : "v"(a), "v"(b)); return r; }
template <bool FIRST>
__device__ __forceinline__ void diff_check(f32x16& c0, f32x16& c1, float& mhat, float& l, float& fpend, bool& pend) {
    float ra = max3f(c0[0], c0[1], c1[0]), rb = max3f(c0[2], c0[3], c1[1]); ra = max3f(ra, c1[2], c1[3]);
#pragma unroll
    for (int r = 4; r < 16; r += 4) { ra = max3f(ra, c0[r], c0[r + 1]); rb = max3f(rb, c0[r + 2], c0[r + 3]); ra = max3f(ra, c1[r], c1[r + 1]); rb = max3f(rb, c1[r + 2], c1[r + 3]); }
    float rm = xmax32(max2f(ra, rb));
    if (FIRST) {
        mhat += rm;
#pragma unroll
        for (int r = 0; r < 16; ++r) { c0[r] -= rm; c1[r] -= rm; }
    } else if (__any(rm > THR)) {
        const float dl = __builtin_fmaxf(rm, 0.f); mhat += dl;
#pragma unroll
        for (int r = 0; r < 16; ++r) { c0[r] -= dl; c1[r] -= dl; }
        const float f = __builtin_amdgcn_exp2f(-dl); l *= f; fpend = f; pend = true;
    }
}
struct DmaHook { const bf16_t* k0; const bf16_t* v0; const bf16_t* v1; LAS unsigned char* dk; LAS unsigned char* dv; bool do_k, do_v;
    __device__ __forceinline__ void operator()() const {
        if (do_k) { __builtin_amdgcn_global_load_lds((const unsigned*)k0, (LAS unsigned*)dk, 16, 0, 0); __builtin_amdgcn_global_load_lds((const unsigned*)(k0 + 64), (LAS unsigned*)(dk + 8192), 16, 0, 0); }
        if (do_v) { __builtin_amdgcn_global_load_lds((const unsigned*)v0, (LAS unsigned*)dv, 16, 0, 0); __builtin_amdgcn_global_load_lds((const unsigned*)v1, (LAS unsigned*)(dv + 1024), 16, 0, 0); } } };
template <bool DO_QK, bool DO_PV, bool DIAG, class Hook>
__device__ __forceinline__ void diff_main(const Hook& hook, f32x16 (&o)[4], f32x16& c0, f32x16& c1, f32x16& n0, f32x16& n1, u32x4 (&pp)[4], float& l,
                                          const bf16x8 (&qv)[4], const LSrc& lk, const LSrc& lv, float mhat, float dq, float nslope, float aslope, float base0, float base1) {
    bf16x8 fr[4];
#define DM_LOAD(j) do { if ((j) < 16) { if (DO_PV) fr[(j) & 3] = lv.v((j) & 3, (j) >> 3, ((j) >> 2) & 1); } else if ((j) < 24) { if (DO_QK) fr[(j) & 3] = lk.k(((j) - 16) & 1, ((j) - 16) >> 1); } } while (0)
    DM_LOAD(0); DM_LOAD(1); DM_LOAD(2);
    float sa = 0.f;
#pragma unroll
    for (int j = 0; j < 24; ++j) {
        if (j == 6) { hook(); __builtin_amdgcn_sched_barrier(0); }
        DM_LOAD(j + 3);
        __builtin_amdgcn_sched_barrier(0);
        if (j < 16) { if (DO_PV) o[j & 3] = __builtin_amdgcn_mfma_f32_32x32x16_bf16(fr[j & 3], __builtin_bit_cast(bf16x8, pp[j >> 2]), o[j & 3], 0, 0, 0); }
        else if (DO_QK) { const int q = j - 16;
            if (q & 1) n1 = __builtin_amdgcn_mfma_f32_32x32x16_bf16(fr[j & 3], qv[q >> 1], n1, 0, 0, 0);
            else       n0 = __builtin_amdgcn_mfma_f32_32x32x16_bf16(fr[j & 3], qv[q >> 1], n0, 0, 0, 0); }
        if (j < 16) { const int r = j;
            c0[r] = __builtin_amdgcn_exp2f(c0[r]); c1[r] = __builtin_amdgcn_exp2f(c1[r]); sa += c0[r]; sa += c1[r];
            if (DO_QK) {
                if (DIAG) { n0[r] = __builtin_fmaf(nslope, __builtin_fabsf(dq - KOFF(r)), -mhat); n1[r] = __builtin_fmaf(nslope, __builtin_fabsf(dq - (KOFF(r) + 32.f)), -mhat); }
                else { n0[r] = __builtin_fmaf(aslope, KOFF(r), base0); n1[r] = n0[r] + base1; } } }
        __builtin_amdgcn_sched_barrier(0);
    }
#undef DM_LOAD
    l += sa;
#pragma unroll
    for (int s = 0; s < 2; ++s) {
        pp[s].x = cvtpk(c0[8 * s + 0], c0[8 * s + 1]); pp[s].y = cvtpk(c0[8 * s + 2], c0[8 * s + 3]); pp[s].z = cvtpk(c0[8 * s + 4], c0[8 * s + 5]); pp[s].w = cvtpk(c0[8 * s + 6], c0[8 * s + 7]);
        pp[2 + s].x = cvtpk(c1[8 * s + 0], c1[8 * s + 1]); pp[2 + s].y = cvtpk(c1[8 * s + 2], c1[8 * s + 3]); pp[2 + s].z = cvtpk(c1[8 * s + 4], c1[8 * s + 5]); pp[2 + s].w = cvtpk(c1[8 * s + 6], c1[8 * s + 7]);
    }
}

__device__ __forceinline__ void diff_unit(int b, int hh, int qb, const bf16_t* QK, const bf16_t* VT, bf16_t* MIX, float lam, LAS unsigned char* lds, int wid, int lane, const unsigned* nrm) {
    const int q32 = lane & 31, h = lane >> 5, m = wid >> 2, qsub = wid & 3;
    const size_t tok0 = (size_t)b * SEQ; const int qpos = qb * 128 + qsub * 32 + q32;
    const float slope2 = __builtin_amdgcn_exp2f(-2.0f * (float)(hh + 1)) * LOG2E;
    int tlo, thi;
    { const unsigned* nr = nrm + b * 32; float sb = 0.f;
#pragma unroll
      for (int mm = 0; mm < 2; ++mm) { const int g = hh * 4 + mm * 2;
        const float q2 = __builtin_bit_cast(float, nr[g]) + __builtin_bit_cast(float, nr[g + 1]), k2 = __builtin_bit_cast(float, nr[16 + g]) + __builtin_bit_cast(float, nr[16 + g + 1]);
        sb = __builtin_fmaxf(sb, __builtin_sqrtf(q2 * k2)); }
      sb *= 1.02f;
      const float dsk = (170.0f + 2.0f * sb) / slope2;
      const int dk = dsk < 8192.f ? (int)dsk + 1 : 8192, q0 = qb * 128;
      tlo = (q0 - dk) > 0 ? ((q0 - dk) >> 6) : 0; thi = (q0 + 127 + dk) < SEQ ? ((q0 + 127 + dk) >> 6) : SEQ / 64 - 1;
      if (((thi - tlo + 1) & 1) != 0) { if (thi < SEQ / 64 - 1) ++thi; else --tlo; }
      tlo = __builtin_amdgcn_readfirstlane(tlo); thi = __builtin_amdgcn_readfirstlane(thi); }
    const int P = lane & 7;
    const bf16_t* ksrc; const bf16_t* vsrc0; const bf16_t* vsrc1;
    { const int R = 8 * wid + (lane >> 3); const int key = 32 * (R >> 5) + pi32(R & 31), c = P ^ ((R >> 1) & 7);
      ksrc = QK + (tok0 + key) * NQK + 512 + hh * 128 + c * 8;
      const int d0 = 16 * wid + (lane >> 3), d1 = d0 + 8;
      vsrc0 = VT + (size_t)(hh * 128 + d0) * MTOK + tok0 + (P ^ ((d0 >> 1) & 7)) * 8;
      vsrc1 = VT + (size_t)(hh * 128 + d1) * MTOK + tok0 + (P ^ ((d1 >> 1) & 7)) * 8; }
    const int t0 = qb * 2, NT = thi - tlo + 1, nleft = t0 - tlo;
#define ATT_TT(j) (((j) < 2) ? (t0 + (j)) : ((((j) - 2) < nleft) ? (tlo + (j) - 2) : (tlo + (j))))
#define ATT_TB(j) (ATT_TT(j) * 64)
#define ATT_ISSUE_K(j, slot) do { LAS unsigned char* sb_ = lds + (slot) * ATT_KSLOT + wid * 1024; const size_t tb_ = (size_t)ATT_TB(j); \
        __builtin_amdgcn_global_load_lds((const unsigned*)(ksrc + tb_ * NQK), (LAS unsigned*)(sb_), 16, 0, 0); \
        __builtin_amdgcn_global_load_lds((const unsigned*)(ksrc + tb_ * NQK + 64), (LAS unsigned*)(sb_ + 8192), 16, 0, 0); } while (0)
#define ATT_ISSUE_V(j, slot) do { LAS unsigned char* sb_ = lds + ATT_VRING + (slot) * ATT_VSLOT + wid * 2048; const size_t tb_ = (size_t)ATT_TB(j); \
        __builtin_amdgcn_global_load_lds((const unsigned*)(vsrc0 + tb_), (LAS unsigned*)(sb_), 16, 0, 0); \
        __builtin_amdgcn_global_load_lds((const unsigned*)(vsrc1 + tb_), (LAS unsigned*)(sb_ + 1024), 16, 0, 0); } while (0)
    ATT_ISSUE_K(0, 0); ATT_ISSUE_K(1, 1); ATT_ISSUE_K(2, 2); ATT_ISSUE_V(0, 0);
    bf16x8 qa[4];
    { const bf16_t* qp = QK + (tok0 + qpos) * NQK + hh * 128 + m * 64 + 8 * h;
#pragma unroll
      for (int d0 = 0; d0 < 4; ++d0) qa[d0] = *(const bf16x8*)(qp + d0 * 16); }
    LSrc lk, lv; { const int x = (q32 >> 1) & 7;
#pragma unroll
      for (int i = 0; i < 4; ++i) { lk.ko[i] = lv.ko[i] = ((2 * i + h) ^ x) * 16; lk.vo[i] = lv.vo[i] = ((2 * i + h) ^ x) * 16; } }
    LAS const unsigned char* kbase = lds + m * 8192 + q32 * 128; LAS const unsigned char* vbase = lds + ATT_VRING + q32 * 128;
    lk.va = vbase; lv.ka = kbase;
    f32x16 o[4];
#pragma unroll
    for (int dt = 0; dt < 4; ++dt) o[dt] = f32x16{};
    float mhat = 0.f, l = 0.f, fpend = 1.0f; bool pend = false;
    f32x16 c0, c1, n0, n1; u32x4 pp[4];
    const float hq = (float)(8 * h - qpos);
    ATT_WAITBAR(6);
    { lk.ka = kbase;
      const float dq = (float)(qpos - ATT_TB(0) - 8 * h);
#pragma unroll
      for (int r = 0; r < 16; ++r) { c0[r] = -slope2 * __builtin_fabsf(dq - KOFF(r)); c1[r] = -slope2 * __builtin_fabsf(dq - (KOFF(r) + 32.f)); }
#pragma unroll
      for (int d0 = 0; d0 < 4; ++d0) { const bf16x8 q = qa[d0];
        c0 = __builtin_amdgcn_mfma_f32_32x32x16_bf16(lk.k(0, d0), q, c0, 0, 0, 0); c1 = __builtin_amdgcn_mfma_f32_32x32x16_bf16(lk.k(1, d0), q, c1, 0, 0, 0); } }
    ATT_WAITBAR(4);
    ATT_ISSUE_K(3, 0); ATT_ISSUE_V(1, 1);
    asm volatile("s_nop 15\n\ts_nop 15\n\ts_nop 15" ::: "memory");
    diff_check<true>(c0, c1, mhat, l, fpend, pend);
    { lk.ka = kbase + ATT_KSLOT;
      diff_main<true, false, true>(DmaHook{nullptr, nullptr, nullptr, lds, lds, false, false}, o, c0, c1, n0, n1, pp, l, qa, lk, lv, mhat, (float)(qpos - ATT_TB(1) - 8 * h), -slope2, 0.f, 0.f, 0.f); }
    int ks = 2, vs = 0;
#define ATT_STEP(i, C0, C1, N0, N1) do { \
        if ((i) + 2 < NT) ATT_WAITBAR(4); else ATT_WAITBAR(2); \
        const int kn_ = (ks == 0) ? 2 : ks - 1, vn_ = (vs == 0) ? 2 : vs - 1;     \
        const DmaHook hk_{ksrc + (size_t)ATT_TB((i) + 3) * NQK, vsrc0 + ATT_TB((i) + 1), vsrc1 + ATT_TB((i) + 1), lds + kn_ * ATT_KSLOT + wid * 1024, lds + ATT_VRING + vn_ * ATT_VSLOT + wid * 2048, (i) + 3 < NT, true}; \
        if (pend) {                                                      \
            _Pragma("unroll") for (int dt = 0; dt < 4; ++dt) _Pragma("unroll") for (int r = 0; r < 16; ++r) o[dt][r] *= fpend; \
            fpend = 1.0f; pend = false; } \
        diff_check<false>(C0, C1, mhat, l, fpend, pend); \
        { const bool left = ((i) - 1) < nleft; const int tb = ATT_TB((i) + 1); \
          const float asl = left ? slope2 : -slope2; const float base0 = asl * ((float)tb + hq) - mhat; \
          lk.ka = kbase + ks * ATT_KSLOT; lv.va = vbase + vs * ATT_VSLOT; \
          diff_main<true, true, false>(hk_, o, C0, C1, N0, N1, pp, l, qa, lk, lv, mhat, 0.f, 0.f, asl, base0, asl * 32.f); } \
        ks = (ks == 2) ? 0 : ks + 1; vs = (vs == 2) ? 0 : vs + 1; } while (0)
    for (int i = 1; i < NT - 1; i += 2) {
        ATT_STEP(i, n0, n1, c0, c1);
        ATT_STEP(i + 1, c0, c1, n0, n1);
    }
#undef ATT_STEP
    ATT_WAITBAR(2);
    if (pend) {
#pragma unroll
        for (int dt = 0; dt < 4; ++dt)
#pragma unroll
            for (int r = 0; r < 16; ++r) o[dt][r] *= fpend;
        fpend = 1.0f; pend = false; }
    diff_check<false>(n0, n1, mhat, l, fpend, pend);
    { lv.va = vbase + vs * ATT_VSLOT;
      diff_main<false, true, false>(DmaHook{nullptr, nullptr, nullptr, lds, lds, false, false}, o, n0, n1, c0, c1, pp, l, qa, lk, lv, mhat, 0.f, 0.f, 0.f, 0.f, 0.f); }
    if (pend) {
#pragma unroll
        for (int dt = 0; dt < 4; ++dt)
#pragma unroll
            for (int r = 0; r < 16; ++r) o[dt][r] *= fpend;
    }
    vs = (vs == 2) ? 0 : vs + 1;
    ATT_WAITBAR(0);
    { lv.va = vbase + vs * ATT_VSLOT;
#pragma unroll
      for (int ts = 0; ts < 4; ++ts) { const bf16x8 pb = __builtin_bit_cast(bf16x8, pp[ts]);
#pragma unroll
        for (int dt = 0; dt < 4; ++dt) o[dt] = __builtin_amdgcn_mfma_f32_32x32x16_bf16(lv.v(dt, ts >> 1, ts & 1), pb, o[dt], 0, 0, 0); } }
#undef ATT_ISSUE_K
#undef ATT_ISSUE_V
#undef ATT_TB
#undef ATT_TT
    const float lt = xsum32(l), inv = 1.0f / lt;
    __syncthreads();
    LAS float* ex = (LAS float*)lds;
    if (m == 1) {
        const float sc = inv * lam;
#pragma unroll
        for (int dt = 0; dt < 4; ++dt)
#pragma unroll
            for (int r = 0; r < 16; ++r) ex[(qsub * 128 + 32 * dt + crow(r, h)) * 32 + q32] = o[dt][r] * sc;
    }
    __syncthreads();
    if (m == 0) {
        float ss = 0.f;
#pragma unroll
        for (int dt = 0; dt < 4; ++dt)
#pragma unroll
            for (int r = 0; r < 16; ++r) { const float v = o[dt][r] * inv - ex[(qsub * 128 + 32 * dt + crow(r, h)) * 32 + q32]; o[dt][r] = v; ss += v * v; }
        ss = xsum32(ss);
        const float rinv = 1.0f / __builtin_sqrtf(ss * (1.0f / 128.f) + EPS);
        bf16_t* op = MIX + (tok0 + qpos) * DM + hh * 128 + 4 * h;
#pragma unroll
        for (int dt = 0; dt < 4; ++dt)
#pragma unroll
            for (int r4 = 0; r4 < 4; ++r4) { u32x2 w; w.x = cvtpk(o[dt][4 * r4] * rinv, o[dt][4 * r4 + 1] * rinv); w.y = cvtpk(o[dt][4 * r4 + 2] * rinv, o[dt][4 * r4 + 3] * rinv);
                *(u32x2*)(op + 32 * dt + 8 * r4) = w; }
    }
    __syncthreads();
}

struct RawTile { u32x4 k[8]; u32x4 v[8]; };
__device__ __forceinline__ int dil_fn(int n) { return 32 * (n >> 2) + 16 * ((n >> 1) & 1) + 4 * (n & 1); }
__device__ __forceinline__ void dil_load(RawTile& r, const bf16_t* kpe, const bf16_t* kpo, const bf16_t* vpe, const bf16_t* vpo, int jb, int lg) {
#pragma unroll
    for (int n = 0; n < 8; ++n) {
        r.k[n] = *(const u32x4*)(((n & 1) ? kpo : kpe) + ((size_t)(jb + dil_fn(n)) << lg) * NQK);
        r.v[n] = *(const u32x4*)(((n & 1) ? vpo : vpe) + (size_t)(8 * n) * MTOK + jb);
    }
}
__device__ __forceinline__ void dil_store(const RawTile& r, LAS unsigned char* lw, int lane) {
#pragma unroll
    for (int n = 0; n < 8; ++n) { *(LAS u32x4*)(lw + n * 1024 + lane * 16) = r.k[n]; *(LAS u32x4*)(lw + 8192 + n * 1024 + lane * 16) = r.v[n]; }
}
struct DilCtx { const bf16_t* kpe; const bf16_t* kpo; const bf16_t* vpe; const bf16_t* vpo; const bf16_t* qp; size_t tokq; float slope2d; int c, lg, L, iq, p, hd; };
__device__ __forceinline__ void dil_setup(DilCtx& x, int u, const bf16_t* QK, const bf16_t* VT, const bf16_t* VT4, const bf16_t* VT16, int lane) {
    const int q32 = lane & 31, h = lane >> 5;
    const int w32 = u & 255; int rest = u >> 8; const int p = rest % 3; rest /= 3; const int hd = rest & 7, b = rest >> 3;
    const int lg = 2 * p, L = SEQ >> lg;
    const int g = w32 >> (8 - lg), i0 = (w32 & ((256 >> lg) - 1)) * 32;
    const size_t tok0 = (size_t)b * SEQ;
    x.p = p; x.hd = hd; x.lg = lg; x.L = L; x.iq = i0 + q32; x.c = i0 & ~63;
    x.tokq = tok0 + ((size_t)x.iq << lg) + g;
    x.slope2d = __builtin_amdgcn_exp2f(-(float)(hd + 1)) * LOG2E * (float)(1 << lg);
    x.qp = QK + x.tokq * NQK + 1024 + hd * 64 + 8 * h;
    const int r8 = lane >> 3, P = lane & 7, c0 = P ^ (r8 >> 1), lpart = (r8 & 3) + 8 * (r8 >> 2);
    const bf16_t* kb_ = QK + (tok0 + ((size_t)lpart << lg) + g) * NQK + 1536 + hd * 64;
    x.kpe = kb_ + c0 * 8; x.kpo = kb_ + (c0 ^ 4) * 8;
    const bf16_t* vsrc = (p == 0) ? VT + (size_t)512 * MTOK : (p == 1 ? VT4 : VT16);
    const bf16_t* vb_ = vsrc + (size_t)(hd * 64 + r8) * MTOK + tok0 + (size_t)g * L;
    x.vpe = vb_ + c0 * 8; x.vpo = vb_ + (c0 ^ 4) * 8;
}
__device__ __forceinline__ void dil_units(int u0, int nu, const bf16_t* QK, const bf16_t* VT, const bf16_t* VT4, const bf16_t* VT16, unsigned char* dout, LAS unsigned char* lw, int lane) {
    if (nu <= 0) return;
    const int q32 = lane & 31, h = lane >> 5;
    LSrc ls; { const int x = (q32 >> 1) & 7;
#pragma unroll
      for (int i = 0; i < 4; ++i) { ls.ko[i] = ((2 * i + h) ^ x) * 16; ls.vo[i] = ((2 * i + h) ^ x) * 16; } }
    ls.ka = lw + q32 * 128; ls.va = lw + 8192 + q32 * 128;
    DilCtx cx; RawTile ra; bf16x8 qn[4];
    dil_setup(cx, u0, QK, VT, VT4, VT16, lane);
    dil_load(ra, cx.kpe, cx.kpo, cx.vpe, cx.vpo, cx.c, cx.lg);
#pragma unroll
    for (int d0 = 0; d0 < 4; ++d0) qn[d0] = *(const bf16x8*)(cx.qp + d0 * 16);
    for (int k = 0; k < nu; ++k) {
        bf16x8 qf[4];
#pragma unroll
        for (int d0 = 0; d0 < 4; ++d0) qf[d0] = qn[d0];
        const DilCtx cu = cx; const bool more = (k + 1 < nu);
        const int c = cu.c, lg = cu.lg; const bool has_l = c >= 64, has_r = c + 64 < cu.L;
        const float nsl = -cu.slope2d; const int iq8 = cu.iq - 8 * h;
#define DIL_NEXT() do { if (more) { dil_setup(cx, u0 + k + 1, QK, VT, VT4, VT16, lane); dil_load(ra, cx.kpe, cx.kpo, cx.vpe, cx.vpo, cx.c, cx.lg); \
            _Pragma("unroll") for (int d0 = 0; d0 < 4; ++d0) qn[d0] = *(const bf16x8*)(cx.qp + d0 * 16); } } while (0)
        f32x16 o[2]; o[0] = f32x16{}; o[1] = f32x16{};
        float mhat = 0.f, l = 0.f;
        dil_store(ra, lw, lane);
        if (has_l) dil_load(ra, cu.kpe, cu.kpo, cu.vpe, cu.vpo, c - 64, lg); else if (has_r) dil_load(ra, cu.kpe, cu.kpo, cu.vpe, cu.vpo, c + 64, lg); else DIL_NEXT();
        attn_tile<2, true, false>(o, mhat, l, qf, ls, (float)(iq8 - c), nsl);
        if (has_l) { dil_store(ra, lw, lane);
            if (has_r) dil_load(ra, cu.kpe, cu.kpo, cu.vpe, cu.vpo, c + 64, lg); else DIL_NEXT();
            attn_tile<2, false, true>(o, mhat, l, qf, ls, (float)(iq8 - (c - 64)), nsl); }
        if (has_r) { dil_store(ra, lw, lane); DIL_NEXT();
            attn_tile<2, false, true>(o, mhat, l, qf, ls, (float)(iq8 - (c + 64)), nsl); }
#undef DIL_NEXT
        const float lt = xsum32(l), inv = 1.0f / lt;
#pragma unroll
        for (int dt = 0; dt < 2; ++dt)
#pragma unroll
            for (int r4 = 0; r4 < 4; ++r4) { u32x2 w; w.x = cvtpk(o[dt][4 * r4] * inv, o[dt][4 * r4 + 1] * inv); w.y = cvtpk(o[dt][4 * r4 + 2] * inv, o[dt][4 * r4 + 3] * inv);
                const int ch = 4 * dt + r4;
                *(LAS u32x2*)(lw + q32 * 128 + ((ch ^ (q32 & 7)) * 16) + 8 * h) = w; }
        { bf16_t* ob = (bf16_t*)(dout + DO_OPART + (size_t)cu.p * DO_OPART_STRIDE) + (cu.tokq - ((size_t)q32 << lg)) * 512 + cu.hd * 64;
          const int rr = lane >> 3, cc = lane & 7;
#pragma unroll
          for (int k2 = 0; k2 < 4; ++k2) { const int q = rr + 8 * k2;
              const u32x4 v = *(LAS const u32x4*)(lw + q * 128 + ((cc ^ (q & 7)) * 16));
              *(u32x4*)(ob + ((size_t)q << lg) * 512 + cc * 8) = v; } }
        if (h == 0) ((float*)(dout + DO_LSE + (size_t)cu.p * DO_LSE_STRIDE))[cu.tokq * 8 + cu.hd] = mhat + __builtin_amdgcn_logf(lt);
    }
}

__device__ __forceinline__ void transpose_item(const float* W, int K, int N, bf16_t* WT, int dst_n0, int k0, int n0, const float* sc1, const float* sc2, float scm, LAS float* scr, int lane) {
#pragma unroll 8
    for (int i = 0; i < 32; ++i) { const int kk = 2 * i + (lane >> 5), k = k0 + kk;
        float s = 1.0f; if (sc1) s = (sc2 && k >= 512) ? sc2[k - 512] : sc1[k] * scm;
        scr[kk * 33 + (lane & 31)] = W[(size_t)k * N + n0 + (lane & 31)] * s; }
    asm volatile("s_waitcnt lgkmcnt(0)" ::: "memory");
    const int c = lane & 7;
#pragma unroll
    for (int j = 0; j < 4; ++j) { const int n = (lane >> 3) + 8 * j; const LAS float* s = scr + (8 * c) * 33 + n;
        u32x4 o; o.x = cvtpk(s[0 * 33], s[1 * 33]); o.y = cvtpk(s[2 * 33], s[3 * 33]); o.z = cvtpk(s[4 * 33], s[5 * 33]); o.w = cvtpk(s[6 * 33], s[7 * 33]);
        *(u32x4*)(WT + (size_t)(dst_n0 + n) * K + k0 + 8 * c) = o; }
    asm volatile("s_waitcnt lgkmcnt(0)" ::: "memory");
}

__global__ void __launch_bounds__(512) hymba_fwd(Args a) {
    extern __shared__ __attribute__((aligned(16))) unsigned char lds_raw[];
    LAS unsigned char* lds = (LAS unsigned char*)lds_raw;
    const int tid = threadIdx.x, lane = tid & 63, wave = __builtin_amdgcn_readfirstlane(tid >> 6);
    const int G = gridDim.x, bx = blockIdx.x;
    const int vcu = (G % 8 == 0) ? (bx % 8) * (G / 8) + bx / 8 : bx;
    const int gw = vcu * 8 + wave, NGW = G * 8;
    unsigned char* ws = a.ws;
    const float* xp = a.in[0]; const float* xs = a.in[1];
    bf16_t* Win_t = (bf16_t*)(ws + WS_WIN); bf16_t* Wout_t = (bf16_t*)(ws + WS_WOUT); bf16_t* Wup_t = (bf16_t*)(ws + WS_WUP); bf16_t* Wdn_t = (bf16_t*)(ws + WS_WDN);
    float* rs1p = (float*)(ws + WS_RS1P); float* part2 = (float*)(ws + WS_PART2); float* part3 = (float*)(ws + WS_PART3);
    bf16_t* XB = (bf16_t*)(ws + WS_XB); bf16_t* MIX = (bf16_t*)(ws + WS_MIX); bf16_t* QK = (bf16_t*)(ws + WS_QK);
    bf16_t* VT = (bf16_t*)(ws + WS_VT); bf16_t* VT4 = (bf16_t*)(ws + WS_VT4); bf16_t* VT16 = (bf16_t*)(ws + WS_VT16);
    bf16_t* U = (bf16_t*)(ws + WS_U); bf16_t* X1B = (bf16_t*)(ws + WS_X1B);
    const int lo = a.ph_lo, hi = a.ph_hi;
#define IN(k) (lo <= (k) && (k) < hi)
    volatile LAS unsigned* bst = (volatile LAS unsigned*)(lds + 131072 + 64);
    if (tid < 2) bst[tid] = 0u;
    __syncthreads();
    XcdBarrier xbar = xcd_barrier_post((unsigned*)(ws + WS_BAR), bst);
#define SEAM(k) do { if (IN(k) && IN((k) + 1)) { if ((k) == 0) cg::this_grid().sync(); else xcd_barrier(xbar); } } while (0)

    if (IN(0)) {
        if (bx == 0 && tid < NSEQ * 32) ((unsigned*)(ws + WS_NRM))[tid] = 0u;
        if (bx == 0 && tid < 8) { ((unsigned*)(ws + WS_NRM))[512 + 64 * tid] = 0u; ((unsigned*)(ws + WS_NRM))[1024 + 64 * tid] = 0u; }
        LAS float* scr = (LAS float*)(lds + wave * 8448);
        constexpr int I_IN = 16 * 96, I_OUT = 16 * 32, I_UP = 16 * 128, I_DN = 64 * 32, NIT = I_IN + I_OUT + I_UP + I_DN;
        for (int it = gw; it < NIT; it += NGW) {
            int r = it;
            if (r < I_IN) { const int kb = r / 96, nb = r % 96, n0 = nb * 32, blk = n0 >> 9; const int dblk = (blk == 2) ? 4 : (blk == 3) ? 2 : (blk == 4) ? 3 : blk;
                transpose_item(a.in[3], DM, 3072, Win_t, dblk * 512 + (n0 & 511), kb * 64, n0, a.in[2], nullptr, 1.0f, scr, lane); continue; } r -= I_IN;
            if (r < I_OUT) { const int kb = r / 32, nb = r % 32; transpose_item(a.in[7], DM, DM, Wout_t, nb * 32, kb * 64, nb * 32, a.in[5], a.in[6], 0.8f, scr, lane); continue; } r -= I_OUT;
            if (r < I_UP) { const int kb = r / 128, nb = r % 128; transpose_item(a.in[9], DM, FF, Wup_t, nb * 32, kb * 64, nb * 32, a.in[8], nullptr, 1.0f, scr, lane); continue; } r -= I_UP;
            { const int kb = r / 32, nb = r % 32; transpose_item(a.in[10], FF, DM, Wdn_t, nb * 32, kb * 64, nb * 32, nullptr, nullptr, 1.0f, scr, lane); }
        }
        for (int m = gw; m < MTOK; m += NGW) {
            const float* xr = (m < PROMPT_ROWS) ? xp + (size_t)m * DM : xs + (size_t)(m - PROMPT_ROWS) * DM;
            f32x4 v[4]; float s2 = 0.f;
#pragma unroll
            for (int j = 0; j < 4; ++j) { v[j] = ((const f32x4*)xr)[lane + 64 * j]; s2 += (v[j][0] * v[j][0] + v[j][1] * v[j][1]) + (v[j][2] * v[j][2] + v[j][3] * v[j][3]); }
            s2 = wave_sum(s2);
            const float rs = 1.0f / __builtin_sqrtf(s2 * (1.0f / DM) + EPS);
            u32x2* o8 = (u32x2*)(XB + (size_t)m * DM) + lane;
#pragma unroll
            for (int j = 0; j < 4; ++j) { u32x2 w; w.x = cvtpk(v[j][0], v[j][1]); w.y = cvtpk(v[j][2], v[j][3]); o8[64 * j] = w; }
            if (lane == 0) { const int sq = m >> 13, t = m & 8191;
                rs1p[m] = rs; rs1p[MTOK + sq * 8192 + (t & 3) * 2048 + (t >> 2)] = rs; rs1p[2 * MTOK + sq * 8192 + (t & 15) * 512 + (t >> 4)] = rs; }
        }
    }
    SEAM(0);
    if (IN(1)) {
        pg8::StaticOrder S;
        { pg8::Gemm g{XB, Win_t, MTOK, NQK, DM, 0}; S.init(MTOK, NQK, G, bx); pg8::EpiQK E{QK, rs1p, (unsigned*)(ws + WS_NRM)}; pg8::gemm_phase<pg8::EpiQK, true>(lds, g, S, E); }
        { pg8::Gemm g{Win_t + (size_t)2048 * DM, XB, 1024, MTOK, DM, 0}; S.init(1024, MTOK, G, bx); pg8::EpiVT E{VT, rs1p, VT4, VT16}; pg8::gemm_phase<pg8::EpiVT, true>(lds, g, S, E); }
    }
    SEAM(1);
    if (IN(2)) {
        const float* lq = a.in[4];
        const float d1 = wave_sum(lq[lane] * lq[64 + lane]), d2 = wave_sum(lq[128 + lane] * lq[192 + lane]);
        const float lam = __expf(d1) - __expf(d2) + 0.2f;
        { unsigned* dqh = (unsigned*)(ws + WS_NRM) + 1024; LAS unsigned* slotw = (LAS unsigned*)(lds + 131072 + 128);
          const int xd0 = (int)(xb_xcc_id() & 7u);
          for (int s = 0; s < 8; ++s) { const int xq = (xd0 + s) & 7;
              for (;;) {
                  __syncthreads();
                  if (tid == 0) *slotw = __hip_atomic_fetch_add(dqh + 64 * xq, 1u, __ATOMIC_RELAXED, __HIP_MEMORY_SCOPE_AGENT);
                  __syncthreads();
                  const unsigned j = *slotw;
                  if (j >= (unsigned)(NSEQ * 32)) break;
                  const int b = (int)(j >> 5), qb = ((32 * (xq & 1) + (int)(j & 31u)) + 23 * b) & 63, hh = ((xq >> 1) + b) & 3;
                  diff_unit(b, hh, qb, QK, VT, MIX, lam, lds, wave, lane, (const unsigned*)(ws + WS_NRM)); } } }
        { constexpr int NDU = NSEQ * 8 * 3 * 256, DCH = 3, NQ = 8, NCHQ = NDU / NQ / DCH; static_assert(NDU % (NQ * DCH) == 0, "chunking");
          unsigned* qheads = (unsigned*)(ws + WS_NRM) + 512;
          const int x0 = (int)(xb_xcc_id() & 7u);
          for (int s = 0; s < NQ; ++s) { const int xq = (x0 + s) & (NQ - 1);
              for (;;) {
                  unsigned ch = 0; if (lane == 0) ch = __hip_atomic_fetch_add(qheads + 64 * xq, 1u, __ATOMIC_RELAXED, __HIP_MEMORY_SCOPE_AGENT);
                  ch = (unsigned)__builtin_amdgcn_readfirstlane((int)ch);
                  if (ch >= (unsigned)NCHQ) break;
                  dil_units(xq * (NDU / NQ) + (int)ch * DCH, DCH, QK, VT, VT4, VT16, (unsigned char*)a.out, lds + wave * 16384, lane); } } }
    }
    SEAM(2);
    if (IN(3)) {
        const unsigned char* dout = (const unsigned char*)a.out;
        for (int m = gw; m < MTOK; m += NGW) {
            const int hd = lane >> 3; float ls[3], mx;
#pragma unroll
            for (int p = 0; p < 3; ++p) ls[p] = ((const float*)(dout + DO_LSE + (size_t)p * DO_LSE_STRIDE))[(size_t)m * 8 + hd];
            mx = __builtin_fmaxf(ls[0], __builtin_fmaxf(ls[1], ls[2]));
            float w[3], wsum = 0.f;
#pragma unroll
            for (int p = 0; p < 3; ++p) { w[p] = __builtin_amdgcn_exp2f(ls[p] - mx); wsum += w[p]; }
            const float wi = 1.0f / wsum; float acc[8];
#pragma unroll
            for (int j = 0; j < 8; ++j) acc[j] = 0.f;
#pragma unroll
            for (int p = 0; p < 3; ++p) { const u32x4 v = *((const u32x4*)((const bf16_t*)(dout + DO_OPART + (size_t)p * DO_OPART_STRIDE) + (size_t)m * 512) + lane); const float wp = w[p] * wi;
                acc[0] += wp * bf_lo(v.x); acc[1] += wp * bf_hi(v.x); acc[2] += wp * bf_lo(v.y); acc[3] += wp * bf_hi(v.y);
                acc[4] += wp * bf_lo(v.z); acc[5] += wp * bf_hi(v.z); acc[6] += wp * bf_lo(v.w); acc[7] += wp * bf_hi(v.w); }
            float ss = 0.f;
#pragma unroll
            for (int j = 0; j < 8; ++j) ss += acc[j] * acc[j];
            ss = wave_sum(ss);
            const float rinv = 1.0f / __builtin_sqrtf(ss * (1.0f / 512.f) + EPS);
            u32x4 o; o.x = cvtpk(acc[0] * rinv, acc[1] * rinv); o.y = cvtpk(acc[2] * rinv, acc[3] * rinv); o.z = cvtpk(acc[4] * rinv, acc[5] * rinv); o.w = cvtpk(acc[6] * rinv, acc[7] * rinv);
            *((u32x4*)(MIX + (size_t)m * DM + 512) + lane) = o;
        }
    }
    SEAM(3);
    if (IN(4)) {
        pg8::StaticOrder S; pg8::Gemm g{MIX, Wout_t, MTOK, DM, DM, 0}; S.init(MTOK, DM, G, bx);
        pg8::EpiResB<true> E{xp, xs, X1B, part2}; pg8::gemm_phase<pg8::EpiResB<true>, true>(lds, g, S, E);
    }
    SEAM(4);
    if (IN(5)) {
        pg8::StaticOrder S; pg8::Gemm g{X1B, Wup_t, MTOK, FF, DM, 0}; S.init(MTOK, FF, G, bx);
        pg8::EpiUp E{U, part2}; pg8::gemm_phase<pg8::EpiUp, true>(lds, g, S, E);
    }
    SEAM(5);
    if (IN(6)) {
        pg8::StaticOrder S; pg8::Gemm g{U, Wdn_t, MTOK, DM, FF, 0}; S.init(MTOK, DM, G, bx);
        pg8::EpiResB<false> E{xp, xs, X1B, part3}; pg8::gemm_phase<pg8::EpiResB<false>, true>(lds, g, S, E);
    }
    SEAM(6);
    if (IN(7)) {
        const float* gf = a.in[11];
        f32x4 gv[2][2];
#pragma unroll
        for (int j = 0; j < 2; ++j) { gv[j][0] = ((const f32x4*)gf)[2 * (lane + 64 * j)]; gv[j][1] = ((const f32x4*)gf)[2 * (lane + 64 * j) + 1]; }
        for (int m0 = gw; m0 < MTOK; m0 += 2 * NGW) {
            u32x4 xv[2][2]; f32x4 pq[2][4];
#pragma unroll
            for (int q = 0; q < 2; ++q) { const int m = (m0 + q * NGW) < MTOK ? (m0 + q * NGW) : m0;
                const f32x4* pp = (const f32x4*)(part3 + (size_t)m * 16); const u32x4* xr = (const u32x4*)(X1B + (size_t)m * DM);
#pragma unroll
                for (int j = 0; j < 4; ++j) pq[q][j] = pp[j];
#pragma unroll
                for (int j = 0; j < 2; ++j) xv[q][j] = xr[lane + 64 * j]; }
#pragma unroll
            for (int q = 0; q < 2; ++q) { const int m = m0 + q * NGW;
                const f32x4 p0 = pq[q][0], p1 = pq[q][1], p2 = pq[q][2], p3 = pq[q][3];
                const float sum = ((p0[0] + p0[1]) + (p0[2] + p0[3])) + ((p1[0] + p1[1]) + (p1[2] + p1[3])) + ((p2[0] + p2[1]) + (p2[2] + p2[3])) + ((p3[0] + p3[1]) + (p3[2] + p3[3]));
                const float rs = 1.0f / __builtin_sqrtf(sum * (1.0f / DM) + EPS);
                f32x4* orow = (f32x4*)(a.out + (size_t)m * DM);
                if (m < MTOK) {
#pragma unroll
                    for (int j = 0; j < 2; ++j) { const u32x4 w = xv[q][j];
                        orow[2 * (lane + 64 * j)] = (f32x4){bf_lo(w.x), bf_hi(w.x), bf_lo(w.y), bf_hi(w.y)} * rs * gv[j][0];
                        orow[2 * (lane + 64 * j) + 1] = (f32x4){bf_lo(w.z), bf_hi(w.z), bf_lo(w.w), bf_hi(w.w)} * rs * gv[j][1]; } } }
        }
    }
#undef IN
#undef SEAM
}

constexpr int N_PHASES = 8;

extern "C" void kernel_launch(void* const* d_in, const int* in_sizes, int n_in, void* d_out, int out_size, void* d_ws, size_t ws_size, hipStream_t stream) {
    static int grid = 0;
    if (grid == 0) {
        if (n_in != 12 || out_size != MTOK * DM || ws_size < WS_END) { fprintf(stderr, "kernel_launch: unexpected shapes (n_in %d, out %d, ws %zu); nothing launched\n", n_in, out_size, ws_size); grid = -1; return; }
        int dev = 0, cus = 0, per_cu = 0;
        hipGetDevice(&dev); hipDeviceGetAttribute(&cus, hipDeviceAttributeMultiprocessorCount, dev);
        if (hipFuncSetAttribute((const void*)hymba_fwd, hipFuncAttributeMaxDynamicSharedMemorySize, LDS_BYTES) != hipSuccess) { fprintf(stderr, "kernel_launch: hipFuncSetAttribute failed\n"); grid = -1; return; }
        if (hipOccupancyMaxActiveBlocksPerMultiprocessor(&per_cu, (const void*)hymba_fwd, 512, LDS_BYTES) != hipSuccess || per_cu < 1) { fprintf(stderr, "kernel_launch: occupancy query says %d\n", per_cu); per_cu = 1; }
        (void)hipGetLastError();
        grid = cus * 1;
        (void)per_cu;
    }
    if (grid < 0) return;
    Args a{};
    for (int i = 0; i < 12; ++i) a.in[i] = (const float*)d_in[i];
    a.out = (float*)d_out; a.ws = (unsigned char*)d_ws;
#if MK_COOP
    (void)hipMemsetAsync((char*)d_ws + WS_BAR, 0, XCD_BAR_WORDS * 4, stream);
    a.ph_lo = 0; a.ph_hi = N_PHASES;
    void* args[] = {&a};
    hipError_t e = hipLaunchCooperativeKernel((const void*)hymba_fwd, dim3(grid), dim3(512), args, LDS_BYTES, stream);
    if (e != hipSuccess) fprintf(stderr, "cooperative launch failed: %s (grid %d)\n", hipGetErrorString(e), grid);
#else
    for (int p = 0; p < N_PHASES; ++p) { a.ph_lo = p; a.ph_hi = p + 1; hipLaunchKernelGGL(hymba_fwd, dim3(grid), dim3(512), LDS_BYTES, stream, a); }
#endif
}
```

```cpp
#include <hip/hip_runtime.h>
#include <hip/hip_cooperative_groups.h>
#include <cstdio>
#include <cstdint>
namespace cg = cooperative_groups;

#ifndef MK_COOP
#define MK_COOP 1
#endif

#define LAS __attribute__((address_space(3)))
typedef unsigned short bf16_t;
typedef short bf16x8 __attribute__((ext_vector_type(8)));
typedef float f32x4 __attribute__((ext_vector_type(4)));
typedef float f32x16 __attribute__((ext_vector_type(16)));
typedef unsigned u32x4 __attribute__((ext_vector_type(4)));
typedef unsigned u32x2 __attribute__((ext_vector_type(2)));

constexpr int SEQ = 8192, NSEQ = 12, MTOK = NSEQ * SEQ, DM = 1024, FF = 4096, NQK = 2048;
constexpr int PROMPT_ROWS = 4 * SEQ;
constexpr float EPS = 1e-5f;
constexpr float LOG2E = 1.4426950408889634f;
constexpr float C2 = 0.125f * LOG2E;

constexpr size_t MiB = 1u << 20;
constexpr size_t WS_WIN = 0, WS_WOUT = 6 * MiB, WS_WUP = 8 * MiB, WS_WDN = 16 * MiB;
constexpr size_t WS_RS1P = 24 * MiB;
constexpr size_t WS_NRM = 25 * MiB + 512 * 1024;
constexpr size_t WS_BAR = 25 * MiB + 768 * 1024;
constexpr size_t WS_PART2 = 26 * MiB;
constexpr size_t WS_PART3 = 32 * MiB;
constexpr size_t WS_XB = 40 * MiB;
constexpr size_t WS_MIX = WS_XB;
constexpr size_t WS_QK = 232 * MiB;
constexpr size_t WS_VT = 616 * MiB;
constexpr size_t WS_VT4 = 808 * MiB;
constexpr size_t WS_VT16 = 904 * MiB;
constexpr size_t WS_U = 40 * MiB;
constexpr size_t WS_X1B = 808 * MiB;
constexpr size_t WS_END = 1000 * MiB;
constexpr size_t DO_OPART = 0, DO_OPART_STRIDE = 96 * MiB, DO_LSE = 288 * MiB, DO_LSE_STRIDE = (size_t)MTOK * 8 * 4;

constexpr int LDS_BYTES = 135168;

__device__ __forceinline__ unsigned f2bf(float f) { unsigned u = __builtin_bit_cast(unsigned, f); return (u + 0x7fffu + ((u >> 16) & 1u)) >> 16; }
typedef float f32x2_t __attribute__((ext_vector_type(2))); typedef __bf16 bf16x2_t __attribute__((ext_vector_type(2)));
__device__ __forceinline__ unsigned cvtpk(float lo, float hi) { f32x2_t v = {lo, hi}; bf16x2_t b = __builtin_convertvector(v, bf16x2_t); return __builtin_bit_cast(unsigned, b); }
__device__ __forceinline__ float bf_lo(unsigned w) { return __builtin_bit_cast(float, w << 16); }
__device__ __forceinline__ float bf_hi(unsigned w) { return __builtin_bit_cast(float, w & 0xffff0000u); }
__device__ __forceinline__ float wave_sum(float v) {
#pragma unroll
    for (int o = 1; o < 64; o <<= 1) v += __shfl_xor(v, o);
    return v;
}
__device__ __forceinline__ void swap32(float& a, float& b) { asm volatile("s_nop 1\n\tv_permlane32_swap_b32 %0, %1\n\ts_nop 1" : "+v"(a), "+v"(b)); }
__device__ __forceinline__ float xmax32(float v) { float a = v, b = v; swap32(a, b); return __builtin_fmaxf(a, b); }
__device__ __forceinline__ float xsum32(float v) { float a = v, b = v; swap32(a, b); return a + b; }

namespace pg8 {
constexpr int BM = 256, BK = 64, HALF = 128, HTB = HALF * BK * 2, STAGE_BYTES = 8 * HTB, NXCD = 8, WGM = 8;
__host__ __device__ __forceinline__ int lds_byte(int r, int c) { const int st = (r >> 4) * 2 + (c >> 5), rr = r & 15, cc = c & 31, ob = rr * 64 + cc * 2; return st * 1024 + (ob ^ (((ob >> 9) & 1) << 5)); }
__host__ __device__ __forceinline__ void stage_rc(int b, int& R, int& C) { const int st = b / 1024, sb = b % 1024, swz = sb ^ (((sb >> 9) & 1) << 5); R = (st >> 1) * 16 + swz / 64; C = (st & 1) * 32 + (swz % 64) / 2; }
__host__ __device__ __forceinline__ int perm32(int rho) { const int n = rho >> 4, i = rho & 15; return 8 * (i >> 2) + 4 * n + (i & 3); }

struct Unit { int pm, pn; };
struct Gemm { const bf16_t* A; const bf16_t* Bt; int M, N, K, blg; };

struct StaticOrder {
    int nM, nN, nwg, G, c, rot;
    __device__ void init(int M, int N, int G_, int c_) { nM = M / BM; nN = N / BM; nwg = nM * nN; G = G_; c = c_; rot = 0; }
    __device__ bool next(int i, Unit& u) const {
        const long L = (long)i * G + c; if (L >= nwg) return false;
        int wgid = (int)L; { const int q = nwg / NXCD, r = nwg % NXCD, xcd = wgid % NXCD, off = wgid / NXCD; wgid = (xcd < r ? xcd * (q + 1) : r * (q + 1) + (xcd - r) * q) + off; }
        const int nig = WGM * nN, gid = wgid / nig, fm = gid * WGM, gsz = (nM - fm) < WGM ? (nM - fm) : WGM;
        u.pm = fm + (((wgid % nig) % gsz + (rot ? i : 0)) % gsz); u.pn = (wgid % nig) / gsz; return true;
    }
};
__device__ __forceinline__ const char* b_base(const Gemm& g, int pn) {
    const int n = pn * BM, seq = n >> 13, nl = n & 8191, lg = g.blg;
    const int gi = nl >> (13 - lg), i0 = nl & ((8192 >> lg) - 1);
    const size_t row = (size_t)seq * 8192 + ((size_t)i0 << lg) + gi;
    return (const char*)g.Bt + row * (size_t)g.K * 2;
}

template <class Epi, bool ALIGN_EPI>
__device__ __forceinline__ void gemm_phase(LAS unsigned char* lds, const Gemm g, const StaticOrder& S, const Epi& E) {
    const int tid = threadIdx.x, wid = __builtin_amdgcn_readfirstlane(tid >> 6), lane = tid & 63, wr = wid >> 2, wc = wid & 3, fr = lane & 15, fq = lane >> 4;
    const int K = g.K, nt = K / BK, lg = g.blg;
    unsigned voffA[2], voffB[2];
#pragma unroll
    for (int i = 0; i < 2; ++i) { int R, C; stage_rc(tid * 16 + i * 8192, R, C); const int Rb = (R & ~31) + perm32(R & 31);
        voffA[i] = (unsigned)(R * K + C) * 2u; voffB[i] = (unsigned)(((Rb << lg) * K) + C) * 2u; }
    const size_t kstep = (size_t)(BK * 2);
    const size_t hstepA = (size_t)HALF * K * 2, hstepB = hstepA << lg;
    const size_t tstepA = 2 * hstepA;
    const unsigned ldsw = (unsigned)wid * 1024u;
    const int aoff = lds_byte(wr * 64 + fr, fq * 8), boff = lds_byte(wc * 32 + fr, fq * 8);
#define PG8_SA(b, h) (((b) * 2 + (h)) * HTB)
#define PG8_SB(b, h) ((4 + (b) * 2 + (h)) * HTB)
#define PG8_STAGE(bufoff, gbase, voff) do { _Pragma("unroll") for (int _i = 0; _i < 2; ++_i) \
        __builtin_amdgcn_global_load_lds((const unsigned*)((const char*)(gbase) + (voff)[_i]), (LAS unsigned*)(lds + (bufoff) + ldsw + _i * 8192), 16, 0, 0); } while (0)
#define PG8_LDA(dst, b, h) do { _Pragma("unroll") for (int m = 0; m < 4; ++m) _Pragma("unroll") for (int k = 0; k < 2; ++k) dst[m][k] = *(const LAS bf16x8*)(lds + PG8_SA(b, h) + aoff + m * 2048 + k * 1024); } while (0)
#define PG8_LDB(dst, b, h) do { _Pragma("unroll") for (int n = 0; n < 2; ++n) _Pragma("unroll") for (int k = 0; k < 2; ++k) dst[n][k] = *(const LAS bf16x8*)(lds + PG8_SB(b, h) + boff + n * 2048 + k * 1024); } while (0)
#define PG8_MMA(ai, bj, At, Bt) do { __builtin_amdgcn_s_setprio(1); _Pragma("unroll") for (int m = 0; m < 4; ++m) _Pragma("unroll") for (int n = 0; n < 2; ++n) _Pragma("unroll") for (int k = 0; k < 2; ++k) \
        acc[ai][bj][m][n] = __builtin_amdgcn_mfma_f32_16x16x32_bf16(Bt[n][k], At[m][k], acc[ai][bj][m][n], 0, 0, 0); __builtin_amdgcn_s_setprio(0); } while (0)
#define PG8_WAIT_V(n) asm volatile("s_waitcnt vmcnt(" #n ")" ::: "memory")
#define PG8_WAIT_L(n) asm volatile("s_waitcnt lgkmcnt(" #n ")" ::: "memory")
#define PG8_BAR __builtin_amdgcn_s_barrier()
#define PG8_SCHED __builtin_amdgcn_sched_barrier(0)
    Unit cur, nxt; int ui = 0;
    if (!S.next(0, cur)) return;
    f32x4 acc[2][2][4][2];
#pragma unroll
    for (int a = 0; a < 2; ++a)
#pragma unroll
        for (int b = 0; b < 2; ++b)
#pragma unroll
            for (int m = 0; m < 4; ++m)
#pragma unroll
                for (int n = 0; n < 2; ++n) acc[a][b][m][n] = (f32x4){0.f, 0.f, 0.f, 0.f};
    bf16x8 At[4][2], B0[2][2], B1[2][2];
    const char* cA = (const char*)g.A + (size_t)cur.pm * tstepA; const char* cB = b_base(g, cur.pn);
    PG8_STAGE(PG8_SB(0, 0), cB, voffB); PG8_STAGE(PG8_SB(0, 1), cB + hstepB, voffB); PG8_STAGE(PG8_SA(0, 0), cA, voffA); PG8_STAGE(PG8_SA(0, 1), cA + hstepA, voffA);
    if (wr == 1) PG8_BAR;
    PG8_WAIT_V(2); PG8_BAR;
    PG8_STAGE(PG8_SB(1, 0), cB + kstep, voffB); PG8_STAGE(PG8_SA(1, 0), cA + kstep, voffA); PG8_STAGE(PG8_SB(1, 1), cB + hstepB + kstep, voffB);
    PG8_WAIT_V(6); PG8_BAR;
    for (;;) {
        const bool has_next = S.next(ui + 1, nxt);
        const char* nA = has_next ? (const char*)g.A + (size_t)nxt.pm * tstepA : cA; const char* nB = has_next ? b_base(g, nxt.pn) : cB;
        for (int t = 0; t < nt; t += 2) {
            const bool last = (t == nt - 2);
            const char* a1 = cA + (size_t)(t + 1) * kstep;
            const char* a2 = last ? nA : cA + (size_t)(t + 2) * kstep; const char* b2 = last ? nB : cB + (size_t)(t + 2) * kstep;
            const char* a3 = a2 + kstep; const char* b3 = b2 + kstep;
            PG8_LDB(B0, 0, 0); PG8_LDB(B1, 0, 1); PG8_SCHED; PG8_LDA(At, 0, 0); PG8_STAGE(PG8_SA(1, 1), a1 + hstepA, voffA);
            PG8_WAIT_V(8); PG8_WAIT_L(0); PG8_BAR; PG8_MMA(0, 0, At, B0); PG8_MMA(0, 1, At, B1); PG8_BAR; PG8_SCHED;
            PG8_LDA(At, 0, 1); PG8_STAGE(PG8_SB(0, 0), b2, voffB); PG8_STAGE(PG8_SB(0, 1), b2 + hstepB, voffB); PG8_STAGE(PG8_SA(0, 0), a2, voffA);
            PG8_WAIT_V(8); PG8_WAIT_L(0); PG8_BAR; PG8_MMA(1, 0, At, B0); PG8_MMA(1, 1, At, B1); PG8_BAR; PG8_SCHED;
            PG8_LDB(B0, 1, 0); PG8_LDB(B1, 1, 1); PG8_SCHED; PG8_LDA(At, 1, 0); PG8_STAGE(PG8_SA(0, 1), a2 + hstepA, voffA);
            PG8_WAIT_V(8); PG8_WAIT_L(0); PG8_BAR; PG8_MMA(0, 0, At, B0); PG8_MMA(0, 1, At, B1); PG8_BAR; PG8_SCHED;
            PG8_LDA(At, 1, 1); PG8_STAGE(PG8_SB(1, 0), b3, voffB); PG8_STAGE(PG8_SB(1, 1), b3 + hstepB, voffB); PG8_STAGE(PG8_SA(1, 0), a3, voffA);
            PG8_WAIT_V(8); PG8_WAIT_L(0); PG8_BAR; PG8_MMA(1, 0, At, B0); PG8_MMA(1, 1, At, B1); PG8_BAR; PG8_SCHED;
        }
        if constexpr (ALIGN_EPI) { if (wr == 0) PG8_BAR; }
        E(acc, cur, wr, wc, fr, fq);
        if (!has_next) break;
#pragma unroll
        for (int a = 0; a < 2; ++a)
#pragma unroll
            for (int b = 0; b < 2; ++b)
#pragma unroll
                for (int m = 0; m < 4; ++m)
#pragma unroll
                    for (int n = 0; n < 2; ++n) acc[a][b][m][n] = (f32x4){0.f, 0.f, 0.f, 0.f};
        cur = nxt; cA = nA; cB = nB; ++ui;
        if constexpr (ALIGN_EPI) { if (wr == 1) PG8_BAR; }
    }
    PG8_WAIT_V(0);
    if constexpr (!ALIGN_EPI) { if (wr == 0) PG8_BAR; }
    PG8_BAR;
#undef PG8_SA
#undef PG8_SB
#undef PG8_STAGE
#undef PG8_LDA
#undef PG8_LDB
#undef PG8_MMA
#undef PG8_WAIT_V
#undef PG8_WAIT_L
#undef PG8_BAR
#undef PG8_SCHED
}

__device__ __forceinline__ u32x4 pack8(f32x4 v0, f32x4 v1) { u32x4 w; w.x = cvtpk(v0[0], v0[1]); w.y = cvtpk(v0[2], v0[3]); w.z = cvtpk(v1[0], v1[1]); w.w = cvtpk(v1[2], v1[3]); return w; }

struct EpiQK {
    bf16_t* O; const float* rs1; unsigned* nrm;
    __device__ __forceinline__ void operator()(const f32x4 (&acc)[2][2][4][2], const Unit& u, int wr, int wc, int fr, int fq) const {
        const int row0 = u.pm * BM + wr * 64 + fr, col0 = u.pn * BM + wc * 32 + 8 * fq;
        const float sct = ((u.pn & 2) == 0) ? C2 : 1.0f;
        float mx[2] = {0.f, 0.f};
#pragma unroll
        for (int ai = 0; ai < 2; ++ai)
#pragma unroll
            for (int m = 0; m < 4; ++m) { const int row = row0 + ai * HALF + m * 16; const float sc = rs1[row] * sct; bf16_t* rowp = O + (size_t)row * NQK + col0;
#pragma unroll
                for (int bj = 0; bj < 2; ++bj) { const f32x4 v0 = acc[ai][bj][m][0] * sc, v1 = acc[ai][bj][m][1] * sc; *(u32x4*)(rowp + bj * HALF) = pack8(v0, v1);
                    if (u.pn < 4) { float ss = (v0[0] * v0[0] + v0[1] * v0[1]) + (v0[2] * v0[2] + v0[3] * v0[3]) + (v1[0] * v1[0] + v1[1] * v1[1]) + (v1[2] * v1[2] + v1[3] * v1[3]);
                        ss += __shfl_xor(ss, 16); ss += __shfl_xor(ss, 32); mx[bj] = __builtin_fmaxf(mx[bj], ss); } } }
        if (u.pn < 4) {
#pragma unroll
            for (int bj = 0; bj < 2; ++bj) { float v = mx[bj];
#pragma unroll
                for (int o = 1; o < 16; o <<= 1) v = __builtin_fmaxf(v, __shfl_xor(v, o));
                if (fr == 0 && fq == 0) atomicMax(nrm + ((u.pm * BM) >> 13) * 32 + u.pn * 8 + bj * 4 + wc, __builtin_bit_cast(unsigned, v)); } }
    }
};
struct EpiVT {
    bf16_t* O; const float* rsp; bf16_t* O4; bf16_t* O16;
    __device__ __forceinline__ void operator()(const f32x4 (&acc)[2][2][4][2], const Unit& u, int wr, int wc, int fr, int fq) const {
        const int row0 = u.pm * BM + wr * 64 + fr, col0 = u.pn * BM + wc * 32 + 8 * fq;
        f32x4 sc[2][2];
#pragma unroll
        for (int bj = 0; bj < 2; ++bj) { sc[bj][0] = *(const f32x4*)(rsp + col0 + bj * HALF); sc[bj][1] = *(const f32x4*)(rsp + col0 + bj * HALF + 4); }
        const bool perm = (u.pm >= 2);
#pragma unroll
        for (int ai = 0; ai < 2; ++ai)
#pragma unroll
            for (int m = 0; m < 4; ++m) { const int row = row0 + ai * HALF + m * 16; bf16_t* rowp = O + (size_t)row * MTOK + col0;
#pragma unroll
                for (int bj = 0; bj < 2; ++bj) { const u32x4 w = pack8(acc[ai][bj][m][0] * sc[bj][0], acc[ai][bj][m][1] * sc[bj][1]); *(u32x4*)(rowp + bj * HALF) = w;
                    if (perm) {
                        const int tg = u.pn * BM + wc * 32 + bj * HALF, sq = tg >> 13, tl = tg & 8191;
                        const size_t rb = (size_t)(row - 512) * MTOK + (size_t)sq * 8192;
                        { const unsigned a0 = (w.x & 0xffffu) | (w.z << 16), a1 = (w.x >> 16) | (w.z & 0xffff0000u), a2 = (w.y & 0xffffu) | (w.w << 16), a3 = (w.y >> 16) | (w.w & 0xffff0000u);
                          const bool lo = (fq & 1) == 0;
                          const unsigned s0 = lo ? a2 : a0, s1 = lo ? a3 : a1;
                          const unsigned r0 = __shfl_xor(s0, 16), r1 = __shfl_xor(s1, 16);
                          u32x2* p4 = (u32x2*)(O4 + rb + (tl >> 2) + 4 * (fq >> 1));
                          if (lo) { p4[0] = (u32x2){a0, r0}; p4[512] = (u32x2){a1, r1}; }
                          else    { p4[1024] = (u32x2){r0, a2}; p4[1536] = (u32x2){r1, a3}; } }
                        { const bool lo = (fq & 2) == 0;
                          const unsigned sx = lo ? w.z : w.x, sy = lo ? w.w : w.y;
                          const unsigned rx = __shfl_xor(sx, 32), ry = __shfl_xor(sy, 32);
                          unsigned* p16 = (unsigned*)(O16 + rb + (size_t)(8 * (fq & 1)) * 512 + (tl >> 4));
                          if (lo) { p16[0] = (w.x & 0xffffu) | (rx << 16); p16[256] = (w.x >> 16) | (rx & 0xffff0000u); p16[512] = (w.y & 0xffffu) | (ry << 16); p16[768] = (w.y >> 16) | (ry & 0xffff0000u); }
                          else    { p16[1024] = (rx & 0xffffu) | (w.z << 16); p16[1280] = (rx >> 16) | (w.z & 0xffff0000u); p16[1536] = (ry & 0xffffu) | (w.w << 16); p16[1792] = (ry >> 16) | (w.w & 0xffff0000u); } } } } }
    }
};
template <bool WITH_BF> struct EpiRes {
    const float* xp; const float* xs; float* out; bf16_t* xb; float* part; bool inplace;
    __device__ __forceinline__ void operator()(const f32x4 (&acc)[2][2][4][2], const Unit& u, int wr, int wc, int fr, int fq) const {
        const int row0 = u.pm * BM + wr * 64 + fr, col0 = u.pn * BM + wc * 32 + 8 * fq;
#pragma unroll
        for (int ai = 0; ai < 2; ++ai)
#pragma unroll
            for (int m = 0; m < 4; ++m) { const int row = row0 + ai * HALF + m * 16;
                const float* bp = inplace ? out + (size_t)row * DM : (row < PROMPT_ROWS ? xp + (size_t)row * DM : xs + (size_t)(row - PROMPT_ROWS) * DM);
                float ss = 0.f;
#pragma unroll
                for (int bj = 0; bj < 2; ++bj) { const int c = col0 + bj * HALF;
                    const f32x4 v0 = acc[ai][bj][m][0] + *(const f32x4*)(bp + c), v1 = acc[ai][bj][m][1] + *(const f32x4*)(bp + c + 4);
                    *(f32x4*)(out + (size_t)row * DM + c) = v0; *(f32x4*)(out + (size_t)row * DM + c + 4) = v1;
                    if (WITH_BF) *(u32x4*)(xb + (size_t)row * DM + c) = pack8(v0, v1);
                    ss += (v0[0] * v0[0] + v0[1] * v0[1]) + (v0[2] * v0[2] + v0[3] * v0[3]) + (v1[0] * v1[0] + v1[1] * v1[1]) + (v1[2] * v1[2] + v1[3] * v1[3]); }
                ss += __shfl_xor(ss, 16); ss += __shfl_xor(ss, 32);
                if (fq == 0) part[(size_t)row * 16 + u.pn * 4 + wc] = ss; }
    }
};
template <bool FROM_X> struct EpiResB {
    const float* xp; const float* xs; bf16_t* xb; float* part;
    __device__ __forceinline__ void operator()(const f32x4 (&acc)[2][2][4][2], const Unit& u, int wr, int wc, int fr, int fq) const {
        const int row0 = u.pm * BM + wr * 64 + fr, col0 = u.pn * BM + wc * 32 + 8 * fq;
#pragma unroll
        for (int ai = 0; ai < 2; ++ai)
#pragma unroll
            for (int m = 0; m < 4; ++m) { const int row = row0 + ai * HALF + m * 16;
                const float* bp = (row < PROMPT_ROWS ? xp + (size_t)row * DM : xs + (size_t)(row - PROMPT_ROWS) * DM);
                float ss = 0.f;
#pragma unroll
                for (int bj = 0; bj < 2; ++bj) { const int c = col0 + bj * HALF; bf16_t* dp = xb + (size_t)row * DM + c;
                    f32x4 b0, b1;
                    if (FROM_X) { b0 = *(const f32x4*)(bp + c); b1 = *(const f32x4*)(bp + c + 4); }
                    else { const u32x4 w = *(const u32x4*)dp; b0 = (f32x4){bf_lo(w.x), bf_hi(w.x), bf_lo(w.y), bf_hi(w.y)}; b1 = (f32x4){bf_lo(w.z), bf_hi(w.z), bf_lo(w.w), bf_hi(w.w)}; }
                    const f32x4 v0 = acc[ai][bj][m][0] + b0, v1 = acc[ai][bj][m][1] + b1;
                    *(u32x4*)dp = pack8(v0, v1);
                    ss += (v0[0] * v0[0] + v0[1] * v0[1]) + (v0[2] * v0[2] + v0[3] * v0[3]) + (v1[0] * v1[0] + v1[1] * v1[1]) + (v1[2] * v1[2] + v1[3] * v1[3]); }
                ss += __shfl_xor(ss, 16); ss += __shfl_xor(ss, 32);
                if (fq == 0) part[(size_t)row * 16 + u.pn * 4 + wc] = ss; }
    }
};
struct EpiUp {
    bf16_t* O; const float* part;
    __device__ __forceinline__ void operator()(const f32x4 (&acc)[2][2][4][2], const Unit& u, int wr, int wc, int fr, int fq) const {
        const int row0 = u.pm * BM + wr * 64 + fr, col0 = u.pn * BM + wc * 32 + 8 * fq;
#pragma unroll
        for (int ai = 0; ai < 2; ++ai)
#pragma unroll
            for (int m = 0; m < 4; ++m) { const int row = row0 + ai * HALF + m * 16; const f32x4* pp = (const f32x4*)(part + (size_t)row * 16);
                const f32x4 p0 = pp[0], p1 = pp[1], p2 = pp[2], p3 = pp[3];
                const float sum = ((p0[0] + p0[1]) + (p0[2] + p0[3])) + ((p1[0] + p1[1]) + (p1[2] + p1[3])) + ((p2[0] + p2[1]) + (p2[2] + p2[3])) + ((p3[0] + p3[1]) + (p3[2] + p3[3]));
                const float r2 = 1.0f / (sum * (1.0f / DM) + EPS); bf16_t* rowp = O + (size_t)row * FF + col0;
#pragma unroll
                for (int bj = 0; bj < 2; ++bj) { f32x4 v0 = acc[ai][bj][m][0], v1 = acc[ai][bj][m][1];
#pragma unroll
                    for (int e = 0; e < 4; ++e) { const float a = __builtin_fmaxf(v0[e], 0.f), b = __builtin_fmaxf(v1[e], 0.f); v0[e] = a * a * r2; v1[e] = b * b * r2; }
                    *(u32x4*)(rowp + bj * HALF) = pack8(v0, v1); } }
    }
};
}

__device__ __forceinline__ int pi32(int r) { return (r & 0x13) | ((r & 4) << 1) | ((r & 8) >> 1); }
__device__ __forceinline__ int crow(int r, int h) { return (r & 3) + 8 * (r >> 2) + 4 * h; }
constexpr float THR = 8.0f;
#define KOFF(r) ((float)(((r) & 7) + 16 * ((r) >> 3)))

struct GSrc { const bf16_t* kp; size_t kts; const bf16_t* vp; size_t vds;
    __device__ __forceinline__ bf16x8 k(int t, int d0) const { return *(const bf16x8*)(kp + t * kts + d0 * 16); }
    __device__ __forceinline__ bf16x8 v(int dt, int t, int s) const { return *(const bf16x8*)(vp + dt * vds + 32 * t + 16 * s); } };
struct LSrc { LAS const unsigned char* ka; LAS const unsigned char* va; int ko[4]; int vo[4];
    __device__ __forceinline__ bf16x8 k(int t, int d0) const { return *(LAS const bf16x8*)(ka + 4096 * t + ko[d0]); }
    __device__ __forceinline__ bf16x8 v(int dt, int t, int s) const { return *(LAS const bf16x8*)(va + 4096 * dt + vo[2 * t + s]); } };

template <int NDT> struct RSrc { bf16x8 kf[2][4]; bf16x8 vf[NDT][2][2];
    __device__ __forceinline__ void load(const GSrc& g) {
#pragma unroll
        for (int t = 0; t < 2; ++t)
#pragma unroll
            for (int d0 = 0; d0 < 4; ++d0) kf[t][d0] = g.k(t, d0);
#pragma unroll
        for (int dt = 0; dt < NDT; ++dt)
#pragma unroll
            for (int t = 0; t < 2; ++t)
#pragma unroll
                for (int s = 0; s < 2; ++s) vf[dt][t][s] = g.v(dt, t, s); }
    __device__ __forceinline__ bf16x8 k(int t, int d0) const { return kf[t][d0]; }
    __device__ __forceinline__ bf16x8 v(int dt, int t, int s) const { return vf[dt][t][s]; } };

template <int NDT, bool FIRST, bool MASK, class Src>
__device__ __forceinline__ void attn_tile(f32x16 (&o)[NDT], float& mhat, float& l, const bf16x8 (&qf)[4], const Src& src, float dq, float nslope) {
    f32x16 s0, s1;
#pragma unroll
    for (int r = 0; r < 16; ++r) {
        const float a0 = __builtin_fabsf(dq - KOFF(r)), a1 = __builtin_fabsf(dq - (KOFF(r) + 32.f));
        s0[r] = __builtin_fmaf(nslope, a0, -mhat); s1[r] = __builtin_fmaf(nslope, a1, -mhat);
        if (MASK) { if (a0 > 64.f) s0[r] = -INFINITY; if (a1 > 64.f) s1[r] = -INFINITY; }
    }
#pragma unroll
    for (int d0 = 0; d0 < 4; ++d0) {
        const bf16x8 k0 = src.k(0, d0), k1 = src.k(1, d0);
        s0 = __builtin_amdgcn_mfma_f32_32x32x16_bf16(k0, qf[d0], s0, 0, 0, 0);
        s1 = __builtin_amdgcn_mfma_f32_32x32x16_bf16(k1, qf[d0], s1, 0, 0, 0);
    }
    float rm = __builtin_fmaxf(s0[0], s1[0]);
#pragma unroll
    for (int r = 1; r < 16; ++r) rm = __builtin_fmaxf(rm, __builtin_fmaxf(s0[r], s1[r]));
    rm = xmax32(rm);
    if (FIRST) {
        mhat += rm;
#pragma unroll
        for (int r = 0; r < 16; ++r) { s0[r] -= rm; s1[r] -= rm; }
    } else if (__any(rm > THR)) {
        const float dl = __builtin_fmaxf(rm, 0.f); mhat += dl;
#pragma unroll
        for (int r = 0; r < 16; ++r) { s0[r] -= dl; s1[r] -= dl; }
        const float f = __builtin_amdgcn_exp2f(-dl); l *= f;
#pragma unroll
        for (int dt = 0; dt < NDT; ++dt)
#pragma unroll
            for (int r = 0; r < 16; ++r) o[dt][r] *= f;
    }
    float sa = 0.f, sb = 0.f;
#pragma unroll
    for (int r = 0; r < 16; ++r) { s0[r] = __builtin_amdgcn_exp2f(s0[r]); s1[r] = __builtin_amdgcn_exp2f(s1[r]); sa += s0[r]; sb += s1[r]; }
    l += sa + sb;
#pragma unroll
    for (int t = 0; t < 2; ++t)
#pragma unroll
        for (int s = 0; s < 2; ++s) {
            u32x4 pw;
            if (t == 0) { pw.x = cvtpk(s0[8 * s + 0], s0[8 * s + 1]); pw.y = cvtpk(s0[8 * s + 2], s0[8 * s + 3]); pw.z = cvtpk(s0[8 * s + 4], s0[8 * s + 5]); pw.w = cvtpk(s0[8 * s + 6], s0[8 * s + 7]); }
            else        { pw.x = cvtpk(s1[8 * s + 0], s1[8 * s + 1]); pw.y = cvtpk(s1[8 * s + 2], s1[8 * s + 3]); pw.z = cvtpk(s1[8 * s + 4], s1[8 * s + 5]); pw.w = cvtpk(s1[8 * s + 6], s1[8 * s + 7]); }
            const bf16x8 pb = __builtin_bit_cast(bf16x8, pw);
#pragma unroll
            for (int dt = 0; dt < NDT; ++dt) {
                const bf16x8 vf = src.v(dt, t, s);
                o[dt] = __builtin_amdgcn_mfma_f32_32x32x16_bf16(vf, pb, o[dt], 0, 0, 0);
            }
        }
}

#define RLX_AGENT __ATOMIC_RELAXED, __HIP_MEMORY_SCOPE_AGENT
#define XB_TMO      128
#define XB_XCNT(j)  (256  + 64 * (j))
#define XB_XSUB(j)  (1280 + 64 * (j))
#define XB_XGEN(j)  (2304 + 64 * (j))
#define XB_TOP      3328
#define XB_TOPGEN   3392
#define XCD_BAR_WORDS 3456
#define XB_SPIN_CAP (1u << 18)

__device__ __forceinline__ unsigned xb_ld(unsigned* p)              { return __hip_atomic_load(p, __ATOMIC_RELAXED, __HIP_MEMORY_SCOPE_AGENT); }
__device__ __forceinline__ unsigned xb_add(unsigned* p, unsigned v) { return __hip_atomic_fetch_add(p, v, __ATOMIC_RELAXED, __HIP_MEMORY_SCOPE_AGENT); }
__device__ __forceinline__ unsigned xb_xcc_id() { return (unsigned)__builtin_amdgcn_s_getreg((3 << 11) | 20) & 0xFu; }
#define XB_SPIN(cond, bar) do { unsigned _sp = 0; while (cond) { __builtin_amdgcn_s_sleep(1); \
    if ((++_sp & 255u) == 0u) { if (xb_ld(&(bar)[XB_TMO])) break; if (_sp > XB_SPIN_CAP) { atomicAdd(&(bar)[XB_TMO], 1u); break; } } } } while (0)

struct XcdBarrier {
    unsigned* bar; unsigned x;
    volatile LAS unsigned* st;
};

__device__ __forceinline__ XcdBarrier xcd_barrier_post(unsigned* bar, volatile LAS unsigned* st) {
    XcdBarrier b; b.bar = bar; b.x = xb_xcc_id(); b.st = st;
    if (threadIdx.x == 0) (void)xb_add(&bar[XB_XCNT(b.x)], 1u);
    return b;
}
__device__ __forceinline__ void xcd_barrier_complete(unsigned* bar, unsigned x, unsigned& nloc, unsigned& nx) {
    const unsigned G = gridDim.x * gridDim.y * gridDim.z;
    unsigned sum, cnt, mine, sp = 0u;
    for (;;) {
        sum = 0u; cnt = 0u; mine = 0u;
#pragma unroll
        for (unsigned j = 0; j < 16; ++j) { const unsigned c = xb_ld(&bar[XB_XCNT(j)]); sum += c; cnt += (c > 0u) ? 1u : 0u; mine = (j == x) ? c : mine; }
        if (sum == G) break;
        __builtin_amdgcn_s_sleep(1);
        if ((++sp & 255u) == 0u) { if (xb_ld(&bar[XB_TMO])) break; if (sp > XB_SPIN_CAP) { atomicAdd(&bar[XB_TMO], 1u); break; } }
    }
    nloc = mine > 0u ? mine : 1u; nx = cnt > 0u ? cnt : 1u;
}

__device__ __forceinline__ void xcd_barrier(const XcdBarrier& b) {
    asm volatile("s_waitcnt vmcnt(0)" ::: "memory");
    __syncthreads();
    if (threadIdx.x == 0) {
        unsigned* bar = b.bar;
        __builtin_amdgcn_s_waitcnt(0);
        unsigned nloc = b.st[0], nx = b.st[1];
        if (nloc == 0u) { xcd_barrier_complete(bar, b.x, nloc, nx); b.st[0] = nloc; b.st[1] = nx; }
        const unsigned old = xb_add(&bar[XB_XSUB(b.x)], 1u);
        const unsigned gen = old / nloc;
        if (old + 1u == (gen + 1u) * nloc) {
            __builtin_amdgcn_fence(__ATOMIC_RELEASE, "agent");
            asm volatile("s_waitcnt vmcnt(0)" ::: "memory");
            const unsigned og = xb_add(&bar[XB_TOP], 1u);
            const unsigned tg = og / nx;
            if (og + 1u == (tg + 1u) * nx) xb_add(&bar[XB_TOPGEN], 1u);
            else XB_SPIN(xb_ld(&bar[XB_TOPGEN]) == tg, bar);
            __builtin_amdgcn_fence(__ATOMIC_ACQUIRE, "agent");
            xb_add(&bar[XB_XGEN(b.x)], 1u);
            asm volatile("s_waitcnt vmcnt(0)" ::: "memory");
        } else {
            XB_SPIN(xb_ld(&bar[XB_XGEN(b.x)]) == gen, bar);
            __builtin_amdgcn_fence(__ATOMIC_ACQUIRE, "agent");
            asm volatile("s_waitcnt vmcnt(0)" ::: "memory");
        }
    }
    __syncthreads();
}


struct Args { const float* in[12]; float* out; unsigned char* ws; int ph_lo, ph_hi; };

constexpr int ATT_KSLOT = 16384, ATT_VRING = 49152, ATT_VSLOT = 16384, ATT_QOFF = 98304;
#define ATT_WAITBAR(N) asm volatile("s_waitcnt vmcnt(" #N ") lgkmcnt(0)\n\ts_barrier" ::: "memory")

__device__ __forceinline__ float max3f(float a, float b, float c) { float r; asm("v_max3_f32 %0, %1, %2, %3" : "=v"(r) : "v"(a), "v"(b), "v"(c)); return r; }
__device__ __forceinline__ float max2f(float a, float b) { float r; asm("v_max_f32_e32 %0, %1, %2" : "=v"(r) : "v"(a), "v"(b)); return r; }
template <bool FIRST>
__device__ __forceinline__ void diff_check(f32x16& c0, f32x16& c1, float& mhat, float& l, float& fpend, bool& pend) {
    float ra = max3f(c0[0], c0[1], c1[0]), rb = max3f(c0[2], c0[3], c1[1]); ra = max3f(ra, c1[2], c1[3]);
#pragma unroll
    for (int r = 4; r < 16; r += 4) { ra = max3f(ra, c0[r], c0[r + 1]); rb = max3f(rb, c0[r + 2], c0[r + 3]); ra = max3f(ra, c1[r], c1[r + 1]); rb = max3f(rb, c1[r + 2], c1[r + 3]); }
    float rm = xmax32(max2f(ra, rb));
    if (FIRST) {
        mhat += rm;
#pragma unroll
        for (int r = 0; r < 16; ++r) { c0[r] -= rm; c1[r] -= rm; }
    } else if (__any(rm > THR)) {
        const float dl = __builtin_fmaxf(rm, 0.f); mhat += dl;
#pragma unroll
        for (int r = 0; r < 16; ++r) { c0[r] -= dl; c1[r] -= dl; }
        const float f = __builtin_amdgcn_exp2f(-dl); l *= f; fpend = f; pend = true;
    }
}
struct DmaHook { const bf16_t* k0; const bf16_t* v0; const bf16_t* v1; LAS unsigned char* dk; LAS unsigned char* dv; bool do_k, do_v;
    __device__ __forceinline__ void operator()() const {
        if (do_k) { __builtin_amdgcn_global_load_lds((const unsigned*)k0, (LAS unsigned*)dk, 16, 0, 0); __builtin_amdgcn_global_load_lds((const unsigned*)(k0 + 64), (LAS unsigned*)(dk + 8192), 16, 0, 0); }
        if (do_v) { __builtin_amdgcn_global_load_lds((const unsigned*)v0, (LAS unsigned*)dv, 16, 0, 0); __builtin_amdgcn_global_load_lds((const unsigned*)v1, (LAS unsigned*)(dv + 1024), 16, 0, 0); } } };
template <bool DO_QK, bool DO_PV, bool DIAG, class Hook>
__device__ __forceinline__ void diff_main(const Hook& hook, f32x16 (&o)[4], f32x16& c0, f32x16& c1, f32x16& n0, f32x16& n1, u32x4 (&pp)[4], float& l,
                                          const bf16x8 (&qv)[4], const LSrc& lk, const LSrc& lv, float mhat, float dq, float nslope, float aslope, float base0, float base1) {
    bf16x8 fr[4];
#define DM_LOAD(j) do { if ((j) < 16) { if (DO_PV) fr[(j) & 3] = lv.v((j) & 3, (j) >> 3, ((j) >> 2) & 1); } else if ((j) < 24) { if (DO_QK) fr[(j) & 3] = lk.k(((j) - 16) & 1, ((j) - 16) >> 1); } } while (0)
    DM_LOAD(0); DM_LOAD(1); DM_LOAD(2);
    float sa = 0.f;
#pragma unroll
    for (int j = 0; j < 24; ++j) {
        if (j == 6) { hook(); __builtin_amdgcn_sched_barrier(0); }
        DM_LOAD(j + 3);
        __builtin_amdgcn_sched_barrier(0);
        if (j < 16) { if (DO_PV) o[j & 3] = __builtin_amdgcn_mfma_f32_32x32x16_bf16(fr[j & 3], __builtin_bit_cast(bf16x8, pp[j >> 2]), o[j & 3], 0, 0, 0); }
        else if (DO_QK) { const int q = j - 16;
            if (q & 1) n1 = __builtin_amdgcn_mfma_f32_32x32x16_bf16(fr[j & 3], qv[q >> 1], n1, 0, 0, 0);
            else       n0 = __builtin_amdgcn_mfma_f32_32x32x16_bf16(fr[j & 3], qv[q >> 1], n0, 0, 0, 0); }
        if (j < 16) { const int r = j;
            c0[r] = __builtin_amdgcn_exp2f(c0[r]); c1[r] = __builtin_amdgcn_exp2f(c1[r]); sa += c0[r]; sa += c1[r];
            if (DO_QK) {
                if (DIAG) { n0[r] = __builtin_fmaf(nslope, __builtin_fabsf(dq - KOFF(r)), -mhat); n1[r] = __builtin_fmaf(nslope, __builtin_fabsf(dq - (KOFF(r) + 32.f)), -mhat); }
                else { n0[r] = __builtin_fmaf(aslope, KOFF(r), base0); n1[r] = n0[r] + base1; } } }
        __builtin_amdgcn_sched_barrier(0);
    }
#undef DM_LOAD
    l += sa;
#pragma unroll
    for (int s = 0; s < 2; ++s) {
        pp[s].x = cvtpk(c0[8 * s + 0], c0[8 * s + 1]); pp[s].y = cvtpk(c0[8 * s + 2], c0[8 * s + 3]); pp[s].z = cvtpk(c0[8 * s + 4], c0[8 * s + 5]); pp[s].w = cvtpk(c0[8 * s + 6], c0[8 * s + 7]);
        pp[2 + s].x = cvtpk(c1[8 * s + 0], c1[8 * s + 1]); pp[2 + s].y = cvtpk(c1[8 * s + 2], c1[8 * s + 3]); pp[2 + s].z = cvtpk(c1[8 * s + 4], c1[8 * s + 5]); pp[2 + s].w = cvtpk(c1[8 * s + 6], c1[8 * s + 7]);
    }
}

__device__ __forceinline__ void diff_unit(int b, int hh, int qb, const bf16_t* QK, const bf16_t* VT, bf16_t* MIX, float lam, LAS unsigned char* lds, int wid, int lane, const unsigned* nrm) {
    const int q32 = lane & 31, h = lane >> 5, m = wid >> 2, qsub = wid & 3;
    const size_t tok0 = (size_t)b * SEQ; const int qpos = qb * 128 + qsub * 32 + q32;
    const float slope2 = __builtin_amdgcn_exp2f(-2.0f * (float)(hh + 1)) * LOG2E;
    int tlo, thi;
    { const unsigned* nr = nrm + b * 32; float sb = 0.f;
#pragma unroll
      for (int mm = 0; mm < 2; ++mm) { const int g = hh * 4 + mm * 2;
        const float q2 = __builtin_bit_cast(float, nr[g]) + __builtin_bit_cast(float, nr[g + 1]), k2 = __builtin_bit_cast(float, nr[16 + g]) + __builtin_bit_cast(float, nr[16 + g + 1]);
        sb = __builtin_fmaxf(sb, __builtin_sqrtf(q2 * k2)); }
      sb *= 1.02f;
      const float dsk = (170.0f + 2.0f * sb) / slope2;
      const int dk = dsk < 8192.f ? (int)dsk + 1 : 8192, q0 = qb * 128;
      tlo = (q0 - dk) > 0 ? ((q0 - dk) >> 6) : 0; thi = (q0 + 127 + dk) < SEQ ? ((q0 + 127 + dk) >> 6) : SEQ / 64 - 1;
      if (((thi - tlo + 1) & 1) != 0) { if (thi < SEQ / 64 - 1) ++thi; else --tlo; }
      tlo = __builtin_amdgcn_readfirstlane(tlo); thi = __builtin_amdgcn_readfirstlane(thi); }
    const int P = lane & 7;
    const bf16_t* ksrc; const bf16_t* vsrc0; const bf16_t* vsrc1;
    { const int R = 8 * wid + (lane >> 3); const int key = 32 * (R >> 5) + pi32(R & 31), c = P ^ ((R >> 1) & 7);
      ksrc = QK + (tok0 + key) * NQK + 512 + hh * 128 + c * 8;
      const int d0 = 16 * wid + (lane >> 3), d1 = d0 + 8;
      vsrc0 = VT + (size_t)(hh * 128 + d0) * MTOK + tok0 + (P ^ ((d0 >> 1) & 7)) * 8;
      vsrc1 = VT + (size_t)(hh * 128 + d1) * MTOK + tok0 + (P ^ ((d1 >> 1) & 7)) * 8; }
    const int t0 = qb * 2, NT = thi - tlo + 1, nleft = t0 - tlo;
#define ATT_TT(j) (((j) < 2) ? (t0 + (j)) : ((((j) - 2) < nleft) ? (tlo + (j) - 2) : (tlo + (j))))
#define ATT_TB(j) (ATT_TT(j) * 64)
#define ATT_ISSUE_K(j, slot) do { LAS unsigned char* sb_ = lds + (slot) * ATT_KSLOT + wid * 1024; const size_t tb_ = (size_t)ATT_TB(j); \
        __builtin_amdgcn_global_load_lds((const unsigned*)(ksrc + tb_ * NQK), (LAS unsigned*)(sb_), 16, 0, 0); \
        __builtin_amdgcn_global_load_lds((const unsigned*)(ksrc + tb_ * NQK + 64), (LAS unsigned*)(sb_ + 8192), 16, 0, 0); } while (0)
#define ATT_ISSUE_V(j, slot) do { LAS unsigned char* sb_ = lds + ATT_VRING + (slot) * ATT_VSLOT + wid * 2048; const size_t tb_ = (size_t)ATT_TB(j); \
        __builtin_amdgcn_global_load_lds((const unsigned*)(vsrc0 + tb_), (LAS unsigned*)(sb_), 16, 0, 0); \
        __builtin_amdgcn_global_load_lds((const unsigned*)(vsrc1 + tb_), (LAS unsigned*)(sb_ + 1024), 16, 0, 0); } while (0)
    ATT_ISSUE_K(0, 0); ATT_ISSUE_K(1, 1); ATT_ISSUE_K(2, 2); ATT_ISSUE_V(0, 0);
    bf16x8 qa[4];
    { const bf16_t* qp = QK + (tok0 + qpos) * NQK + hh * 128 + m * 64 + 8 * h;
#pragma unroll
      for (int d0 = 0; d0 < 4; ++d0) qa[d0] = *(const bf16x8*)(qp + d0 * 16); }
    LSrc lk, lv; { const int x = (q32 >> 1) & 7;
#pragma unroll
      for (int i = 0; i < 4; ++i) { lk.ko[i] = lv.ko[i] = ((2 * i + h) ^ x) * 16; lk.vo[i] = lv.vo[i] = ((2 * i + h) ^ x) * 16; } }
    LAS const unsigned char* kbase = lds + m * 8192 + q32 * 128; LAS const unsigned char* vbase = lds + ATT_VRING + q32 * 128;
    lk.va = vbase; lv.ka = kbase;
    f32x16 o[4];
#pragma unroll
    for (int dt = 0; dt < 4; ++dt) o[dt] = f32x16{};
    float mhat = 0.f, l = 0.f, fpend = 1.0f; bool pend = false;
    f32x16 c0, c1, n0, n1; u32x4 pp[4];
    const float hq = (float)(8 * h - qpos);
    ATT_WAITBAR(6);
    { lk.ka = kbase;
      const float dq = (float)(qpos - ATT_TB(0) - 8 * h);
#pragma unroll
      for (int r = 0; r < 16; ++r) { c0[r] = -slope2 * __builtin_fabsf(dq - KOFF(r)); c1[r] = -slope2 * __builtin_fabsf(dq - (KOFF(r) + 32.f)); }
#pragma unroll
      for (int d0 = 0; d0 < 4; ++d0) { const bf16x8 q = qa[d0];
        c0 = __builtin_amdgcn_mfma_f32_32x32x16_bf16(lk.k(0, d0), q, c0, 0, 0, 0); c1 = __builtin_amdgcn_mfma_f32_32x32x16_bf16(lk.k(1, d0), q, c1, 0, 0, 0); } }
    ATT_WAITBAR(4);
    ATT_ISSUE_K(3, 0); ATT_ISSUE_V(1, 1);
    asm volatile("s_nop 15\n\ts_nop 15\n\ts_nop 15" ::: "memory");
    diff_check<true>(c0, c1, mhat, l, fpend, pend);
    { lk.ka = kbase + ATT_KSLOT;
      diff_main<true, false, true>(DmaHook{nullptr, nullptr, nullptr, lds, lds, false, false}, o, c0, c1, n0, n1, pp, l, qa, lk, lv, mhat, (float)(qpos - ATT_TB(1) - 8 * h), -slope2, 0.f, 0.f, 0.f); }
    int ks = 2, vs = 0;
#define ATT_STEP(i, C0, C1, N0, N1) do { \
        if ((i) + 2 < NT) ATT_WAITBAR(4); else ATT_WAITBAR(2); \
        const int kn_ = (ks == 0) ? 2 : ks - 1, vn_ = (vs == 0) ? 2 : vs - 1;     \
        const DmaHook hk_{ksrc + (size_t)ATT_TB((i) + 3) * NQK, vsrc0 + ATT_TB((i) + 1), vsrc1 + ATT_TB((i) + 1), lds + kn_ * ATT_KSLOT + wid * 1024, lds + ATT_VRING + vn_ * ATT_VSLOT + wid * 2048, (i) + 3 < NT, true}; \
        if (pend) {                                                      \
            _Pragma("unroll") for (int dt = 0; dt < 4; ++dt) _Pragma("unroll") for (int r = 0; r < 16; ++r) o[dt][r] *= fpend; \
            fpend = 1.0f; pend = false; } \
        diff_check<false>(C0, C1, mhat, l, fpend, pend); \
        { const bool left = ((i) - 1) < nleft; const int tb = ATT_TB((i) + 1); \
          const float asl = left ? slope2 : -slope2; const float base0 = asl * ((float)tb + hq) - mhat; \
          lk.ka = kbase + ks * ATT_KSLOT; lv.va = vbase + vs * ATT_VSLOT; \
          diff_main<true, true, false>(hk_, o, C0, C1, N0, N1, pp, l, qa, lk, lv, mhat, 0.f, 0.f, asl, base0, asl * 32.f); } \
        ks = (ks == 2) ? 0 : ks + 1; vs = (vs == 2) ? 0 : vs + 1; } while (0)
    for (int i = 1; i < NT - 1; i += 2) {
        ATT_STEP(i, n0, n1, c0, c1);
        ATT_STEP(i + 1, c0, c1, n0, n1);
    }
#undef ATT_STEP
    ATT_WAITBAR(2);
    if (pend) {
#pragma unroll
        for (int dt = 0; dt < 4; ++dt)
#pragma unroll
            for (int r = 0; r < 16; ++r) o[dt][r] *= fpend;
        fpend = 1.0f; pend = false; }
    diff_check<false>(n0, n1, mhat, l, fpend, pend);
    { lv.va = vbase + vs * ATT_VSLOT;
      diff_main<false, true, false>(DmaHook{nullptr, nullptr, nullptr, lds, lds, false, false}, o, n0, n1, c0, c1, pp, l, qa, lk, lv, mhat, 0.f, 0.f, 0.f, 0.f, 0.f); }
    if (pend) {
#pragma unroll
        for (int dt = 0; dt < 4; ++dt)
#pragma unroll
            for (int r = 0; r < 16; ++r) o[dt][r] *= fpend;
    }
    vs = (vs == 2) ? 0 : vs + 1;
    ATT_WAITBAR(0);
    { lv.va = vbase + vs * ATT_VSLOT;
#pragma unroll
      for (int ts = 0; ts < 4; ++ts) { const bf16x8 pb = __builtin_bit_cast(bf16x8, pp[ts]);
#pragma unroll
        for (int dt = 0; dt < 4; ++dt) o[dt] = __builtin_amdgcn_mfma_f32_32x32x16_bf16(lv.v(dt, ts >> 1, ts & 1), pb, o[dt], 0, 0, 0); } }
#undef ATT_ISSUE_K
#undef ATT_ISSUE_V
#undef ATT_TB
#undef ATT_TT
    const float lt = xsum32(l), inv = 1.0f / lt;
    __syncthreads();
    LAS float* ex = (LAS float*)lds;
    if (m == 1) {
        const float sc = inv * lam;
#pragma unroll
        for (int dt = 0; dt < 4; ++dt)
#pragma unroll
            for (int r = 0; r < 16; ++r) ex[(qsub * 128 + 32 * dt + crow(r, h)) * 32 + q32] = o[dt][r] * sc;
    }
    __syncthreads();
    if (m == 0) {
        float ss = 0.f;
#pragma unroll
        for (int dt = 0; dt < 4; ++dt)
#pragma unroll
            for (int r = 0; r < 16; ++r) { const float v = o[dt][r] * inv - ex[(qsub * 128 + 32 * dt + crow(r, h)) * 32 + q32]; o[dt][r] = v; ss += v * v; }
        ss = xsum32(ss);
        const float rinv = 1.0f / __builtin_sqrtf(ss * (1.0f / 128.f) + EPS);
        bf16_t* op = MIX + (tok0 + qpos) * DM + hh * 128 + 4 * h;
#pragma unroll
        for (int dt = 0; dt < 4; ++dt)
#pragma unroll
            for (int r4 = 0; r4 < 4; ++r4) { u32x2 w; w.x = cvtpk(o[dt][4 * r4] * rinv, o[dt][4 * r4 + 1] * rinv); w.y = cvtpk(o[dt][4 * r4 + 2] * rinv, o[dt][4 * r4 + 3] * rinv);
                *(u32x2*)(op + 32 * dt + 8 * r4) = w; }
    }
    __syncthreads();
}

struct RawTile { u32x4 k[8]; u32x4 v[8]; };
__device__ __forceinline__ int dil_fn(int n) { return 32 * (n >> 2) + 16 * ((n >> 1) & 1) + 4 * (n & 1); }
__device__ __forceinline__ void dil_load(RawTile& r, const bf16_t* kpe, const bf16_t* kpo, const bf16_t* vpe, const bf16_t* vpo, int jb, int lg) {
#pragma unroll
    for (int n = 0; n < 8; ++n) {
        r.k[n] = *(const u32x4*)(((n & 1) ? kpo : kpe) + ((size_t)(jb + dil_fn(n)) << lg) * NQK);
        r.v[n] = *(const u32x4*)(((n & 1) ? vpo : vpe) + (size_t)(8 * n) * MTOK + jb);
    }
}
__device__ __forceinline__ void dil_store(const RawTile& r, LAS unsigned char* lw, int lane) {
#pragma unroll
    for (int n = 0; n < 8; ++n) { *(LAS u32x4*)(lw + n * 1024 + lane * 16) = r.k[n]; *(LAS u32x4*)(lw + 8192 + n * 1024 + lane * 16) = r.v[n]; }
}
struct DilCtx { const bf16_t* kpe; const bf16_t* kpo; const bf16_t* vpe; const bf16_t* vpo; const bf16_t* qp; size_t tokq; float slope2d; int c, lg, L, iq, p, hd; };
__device__ __forceinline__ void dil_setup(DilCtx& x, int u, const bf16_t* QK, const bf16_t* VT, const bf16_t* VT4, const bf16_t* VT16, int lane) {
    const int q32 = lane & 31, h = lane >> 5;
    const int w32 = u & 255; int rest = u >> 8; const int p = rest % 3; rest /= 3; const int hd = rest & 7, b = rest >> 3;
    const int lg = 2 * p, L = SEQ >> lg;
    const int g = w32 >> (8 - lg), i0 = (w32 & ((256 >> lg) - 1)) * 32;
    const size_t tok0 = (size_t)b * SEQ;
    x.p = p; x.hd = hd; x.lg = lg; x.L = L; x.iq = i0 + q32; x.c = i0 & ~63;
    x.tokq = tok0 + ((size_t)x.iq << lg) + g;
    x.slope2d = __builtin_amdgcn_exp2f(-(float)(hd + 1)) * LOG2E * (float)(1 << lg);
    x.qp = QK + x.tokq * NQK + 1024 + hd * 64 + 8 * h;
    const int r8 = lane >> 3, P = lane & 7, c0 = P ^ (r8 >> 1), lpart = (r8 & 3) + 8 * (r8 >> 2);
    const bf16_t* kb_ = QK + (tok0 + ((size_t)lpart << lg) + g) * NQK + 1536 + hd * 64;
    x.kpe = kb_ + c0 * 8; x.kpo = kb_ + (c0 ^ 4) * 8;
    const bf16_t* vsrc = (p == 0) ? VT + (size_t)512 * MTOK : (p == 1 ? VT4 : VT16);
    const bf16_t* vb_ = vsrc + (size_t)(hd * 64 + r8) * MTOK + tok0 + (size_t)g * L;
    x.vpe = vb_ + c0 * 8; x.vpo = vb_ + (c0 ^ 4) * 8;
}
__device__ __forceinline__ void dil_units(int u0, int nu, const bf16_t* QK, const bf16_t* VT, const bf16_t* VT4, const bf16_t* VT16, unsigned char* dout, LAS unsigned char* lw, int lane) {
    if (nu <= 0) return;
    const int q32 = lane & 31, h = lane >> 5;
    LSrc ls; { const int x = (q32 >> 1) & 7;
#pragma unroll
      for (int i = 0; i < 4; ++i) { ls.ko[i] = ((2 * i + h) ^ x) * 16; ls.vo[i] = ((2 * i + h) ^ x) * 16; } }
    ls.ka = lw + q32 * 128; ls.va = lw + 8192 + q32 * 128;
    DilCtx cx; RawTile ra; bf16x8 qn[4];
    dil_setup(cx, u0, QK, VT, VT4, VT16, lane);
    dil_load(ra, cx.kpe, cx.kpo, cx.vpe, cx.vpo, cx.c, cx.lg);
#pragma unroll
    for (int d0 = 0; d0 < 4; ++d0) qn[d0] = *(const bf16x8*)(cx.qp + d0 * 16);
    for (int k = 0; k < nu; ++k) {
        bf16x8 qf[4];
#pragma unroll
        for (int d0 = 0; d0 < 4; ++d0) qf[d0] = qn[d0];
        const DilCtx cu = cx; const bool more = (k + 1 < nu);
        const int c = cu.c, lg = cu.lg; const bool has_l = c >= 64, has_r = c + 64 < cu.L;
        const float nsl = -cu.slope2d; const int iq8 = cu.iq - 8 * h;
#define DIL_NEXT() do { if (more) { dil_setup(cx, u0 + k + 1, QK, VT, VT4, VT16, lane); dil_load(ra, cx.kpe, cx.kpo, cx.vpe, cx.vpo, cx.c, cx.lg); \
            _Pragma("unroll") for (int d0 = 0; d0 < 4; ++d0) qn[d0] = *(const bf16x8*)(cx.qp + d0 * 16); } } while (0)
        f32x16 o[2]; o[0] = f32x16{}; o[1] = f32x16{};
        float mhat = 0.f, l = 0.f;
        dil_store(ra, lw, lane);
        if (has_l) dil_load(ra, cu.kpe, cu.kpo, cu.vpe, cu.vpo, c - 64, lg); else if (has_r) dil_load(ra, cu.kpe, cu.kpo, cu.vpe, cu.vpo, c + 64, lg); else DIL_NEXT();
        attn_tile<2, true, false>(o, mhat, l, qf, ls, (float)(iq8 - c), nsl);
        if (has_l) { dil_store(ra, lw, lane);
            if (has_r) dil_load(ra, cu.kpe, cu.kpo, cu.vpe, cu.vpo, c + 64, lg); else DIL_NEXT();
            attn_tile<2, false, true>(o, mhat, l, qf, ls, (float)(iq8 - (c - 64)), nsl); }
        if (has_r) { dil_store(ra, lw, lane); DIL_NEXT();
            attn_tile<2, false, true>(o, mhat, l, qf, ls, (float)(iq8 - (c + 64)), nsl); }
#undef DIL_NEXT
        const float lt = xsum32(l), inv = 1.0f / lt;
#pragma unroll
        for (int dt = 0; dt < 2; ++dt)
#pragma unroll
            for (int r4 = 0; r4 < 4; ++r4) { u32x2 w; w.x = cvtpk(o[dt][4 * r4] * inv, o[dt][4 * r4 + 1] * inv); w.y = cvtpk(o[dt][4 * r4 + 2] * inv, o[dt][4 * r4 + 3] * inv);
                const int ch = 4 * dt + r4;
                *(LAS u32x2*)(lw + q32 * 128 + ((ch ^ (q32 & 7)) * 16) + 8 * h) = w; }
        { bf16_t* ob = (bf16_t*)(dout + DO_OPART + (size_t)cu.p * DO_OPART_STRIDE) + (cu.tokq - ((size_t)q32 << lg)) * 512 + cu.hd * 64;
          const int rr = lane >> 3, cc = lane & 7;
#pragma unroll
          for (int k2 = 0; k2 < 4; ++k2) { const int q = rr + 8 * k2;
              const u32x4 v = *(LAS const u32x4*)(lw + q * 128 + ((cc ^ (q & 7)) * 16));
              *(u32x4*)(ob + ((size_t)q << lg) * 512 + cc * 8) = v; } }
        if (h == 0) ((float*)(dout + DO_LSE + (size_t)cu.p * DO_LSE_STRIDE))[cu.tokq * 8 + cu.hd] = mhat + __builtin_amdgcn_logf(lt);
    }
}

__device__ __forceinline__ void transpose_item(const float* W, int K, int N, bf16_t* WT, int dst_n0, int k0, int n0, const float* sc1, const float* sc2, float scm, LAS float* scr, int lane) {
#pragma unroll 8
    for (int i = 0; i < 32; ++i) { const int kk = 2 * i + (lane >> 5), k = k0 + kk;
        float s = 1.0f; if (sc1) s = (sc2 && k >= 512) ? sc2[k - 512] : sc1[k] * scm;
        scr[kk * 33 + (lane & 31)] = W[(size_t)k * N + n0 + (lane & 31)] * s; }
    asm volatile("s_waitcnt lgkmcnt(0)" ::: "memory");
    const int c = lane & 7;
#pragma unroll
    for (int j = 0; j < 4; ++j) { const int n = (lane >> 3) + 8 * j; const LAS float* s = scr + (8 * c) * 33 + n;
        u32x4 o; o.x = cvtpk(s[0 * 33], s[1 * 33]); o.y = cvtpk(s[2 * 33], s[3 * 33]); o.z = cvtpk(s[4 * 33], s[5 * 33]); o.w = cvtpk(s[6 * 33], s[7 * 33]);
        *(u32x4*)(WT + (size_t)(dst_n0 + n) * K + k0 + 8 * c) = o; }
    asm volatile("s_waitcnt lgkmcnt(0)" ::: "memory");
}

__global__ void __launch_bounds__(512) hymba_fwd(Args a) {
    extern __shared__ __attribute__((aligned(16))) unsigned char lds_raw[];
    LAS unsigned char* lds = (LAS unsigned char*)lds_raw;
    const int tid = threadIdx.x, lane = tid & 63, wave = __builtin_amdgcn_readfirstlane(tid >> 6);
    const int G = gridDim.x, bx = blockIdx.x;
    const int vcu = (G % 8 == 0) ? (bx % 8) * (G / 8) + bx / 8 : bx;
    const int gw = vcu * 8 + wave, NGW = G * 8;
    unsigned char* ws = a.ws;
    const float* xp = a.in[0]; const float* xs = a.in[1];
    bf16_t* Win_t = (bf16_t*)(ws + WS_WIN); bf16_t* Wout_t = (bf16_t*)(ws + WS_WOUT); bf16_t* Wup_t = (bf16_t*)(ws + WS_WUP); bf16_t* Wdn_t = (bf16_t*)(ws + WS_WDN);
    float* rs1p = (float*)(ws + WS_RS1P); float* part2 = (float*)(ws + WS_PART2); float* part3 = (float*)(ws + WS_PART3);
    bf16_t* XB = (bf16_t*)(ws + WS_XB); bf16_t* MIX = (bf16_t*)(ws + WS_MIX); bf16_t* QK = (bf16_t*)(ws + WS_QK);
    bf16_t* VT = (bf16_t*)(ws + WS_VT); bf16_t* VT4 = (bf16_t*)(ws + WS_VT4); bf16_t* VT16 = (bf16_t*)(ws + WS_VT16);
    bf16_t* U = (bf16_t*)(ws + WS_U); bf16_t* X1B = (bf16_t*)(ws + WS_X1B);
    const int lo = a.ph_lo, hi = a.ph_hi;
#define IN(k) (lo <= (k) && (k) < hi)
    volatile LAS unsigned* bst = (volatile LAS unsigned*)(lds + 131072 + 64);
    if (tid < 2) bst[tid] = 0u;
    __syncthreads();
    XcdBarrier xbar = xcd_barrier_post((unsigned*)(ws + WS_BAR), bst);
#define SEAM(k) do { if (IN(k) && IN((k) + 1)) { if ((k) == 0) cg::this_grid().sync(); else xcd_barrier(xbar); } } while (0)

    if (IN(0)) {
        if (bx == 0 && tid < NSEQ * 32) ((unsigned*)(ws + WS_NRM))[tid] = 0u;
        if (bx == 0 && tid < 8) ((unsigned*)(ws + WS_NRM))[512 + 64 * tid] = 0u;
        LAS float* scr = (LAS float*)(lds + wave * 8448);
        constexpr int I_IN = 16 * 96, I_OUT = 16 * 32, I_UP = 16 * 128, I_DN = 64 * 32, NIT = I_IN + I_OUT + I_UP + I_DN;
        for (int it = gw; it < NIT; it += NGW) {
            int r = it;
            if (r < I_IN) { const int kb = r / 96, nb = r % 96, n0 = nb * 32, blk = n0 >> 9; const int dblk = (blk == 2) ? 4 : (blk == 3) ? 2 : (blk == 4) ? 3 : blk;
                transpose_item(a.in[3], DM, 3072, Win_t, dblk * 512 + (n0 & 511), kb * 64, n0, a.in[2], nullptr, 1.0f, scr, lane); continue; } r -= I_IN;
            if (r < I_OUT) { const int kb = r / 32, nb = r % 32; transpose_item(a.in[7], DM, DM, Wout_t, nb * 32, kb * 64, nb * 32, a.in[5], a.in[6], 0.8f, scr, lane); continue; } r -= I_OUT;
            if (r < I_UP) { const int kb = r / 128, nb = r % 128; transpose_item(a.in[9], DM, FF, Wup_t, nb * 32, kb * 64, nb * 32, a.in[8], nullptr, 1.0f, scr, lane); continue; } r -= I_UP;
            { const int kb = r / 32, nb = r % 32; transpose_item(a.in[10], FF, DM, Wdn_t, nb * 32, kb * 64, nb * 32, nullptr, nullptr, 1.0f, scr, lane); }
        }
        for (int m = gw; m < MTOK; m += NGW) {
            const float* xr = (m < PROMPT_ROWS) ? xp + (size_t)m * DM : xs + (size_t)(m - PROMPT_ROWS) * DM;
            f32x4 v[4]; float s2 = 0.f;
#pragma unroll
            for (int j = 0; j < 4; ++j) { v[j] = ((const f32x4*)xr)[lane + 64 * j]; s2 += (v[j][0] * v[j][0] + v[j][1] * v[j][1]) + (v[j][2] * v[j][2] + v[j][3] * v[j][3]); }
            s2 = wave_sum(s2);
            const float rs = 1.0f / __builtin_sqrtf(s2 * (1.0f / DM) + EPS);
            u32x2* o8 = (u32x2*)(XB + (size_t)m * DM) + lane;
#pragma unroll
            for (int j = 0; j < 4; ++j) { u32x2 w; w.x = cvtpk(v[j][0], v[j][1]); w.y = cvtpk(v[j][2], v[j][3]); o8[64 * j] = w; }
            if (lane == 0) { const int sq = m >> 13, t = m & 8191;
                rs1p[m] = rs; rs1p[MTOK + sq * 8192 + (t & 3) * 2048 + (t >> 2)] = rs; rs1p[2 * MTOK + sq * 8192 + (t & 15) * 512 + (t >> 4)] = rs; }
        }
    }
    SEAM(0);
    if (IN(1)) {
        pg8::StaticOrder S;
        { pg8::Gemm g{XB, Win_t, MTOK, NQK, DM, 0}; S.init(MTOK, NQK, G, bx); pg8::EpiQK E{QK, rs1p, (unsigned*)(ws + WS_NRM)}; pg8::gemm_phase<pg8::EpiQK, true>(lds, g, S, E); }
        { pg8::Gemm g{Win_t + (size_t)2048 * DM, XB, 1024, MTOK, DM, 0}; S.init(1024, MTOK, G, bx); S.rot = 1;     pg8::EpiVT E{VT, rs1p, VT4, VT16}; pg8::gemm_phase<pg8::EpiVT, true>(lds, g, S, E); }
    }
    SEAM(1);
    if (IN(2)) {
        const float* lq = a.in[4];
        const float d1 = wave_sum(lq[lane] * lq[64 + lane]), d2 = wave_sum(lq[128 + lane] * lq[192 + lane]);
        const float lam = __expf(d1) - __expf(d2) + 0.2f;
        for (int u = vcu; u < NSEQ * 4 * 64; u += G) { const int bh = u >> 6, qb = ((u & 63) + 23 * (bh >> 2)) & 63;
            diff_unit(bh >> 2, ((bh & 3) + (bh >> 2)) & 3, qb, QK, VT, MIX, lam, lds, wave, lane, (const unsigned*)(ws + WS_NRM)); }
        { constexpr int NDU = NSEQ * 8 * 3 * 256, DCH = 3, NQ = 8, NCHQ = NDU / NQ / DCH; static_assert(NDU % (NQ * DCH) == 0, "chunking");
          unsigned* qheads = (unsigned*)(ws + WS_NRM) + 512;
          const int x0 = (int)(xb_xcc_id() & 7u);
          for (int s = 0; s < NQ; ++s) { const int xq = (x0 + s) & (NQ - 1);
              for (;;) {
                  unsigned ch = 0; if (lane == 0) ch = __hip_atomic_fetch_add(qheads + 64 * xq, 1u, __ATOMIC_RELAXED, __HIP_MEMORY_SCOPE_AGENT);
                  ch = (unsigned)__builtin_amdgcn_readfirstlane((int)ch);
                  if (ch >= (unsigned)NCHQ) break;
                  dil_units(xq * (NDU / NQ) + (int)ch * DCH, DCH, QK, VT, VT4, VT16, (unsigned char*)a.out, lds + wave * 16384, lane); } } }
    }
    SEAM(2);
    if (IN(3)) {
        const unsigned char* dout = (const unsigned char*)a.out;
        for (int m = gw; m < MTOK; m += NGW) {
            const int hd = lane >> 3; float ls[3], mx;
#pragma unroll
            for (int p = 0; p < 3; ++p) ls[p] = ((const float*)(dout + DO_LSE + (size_t)p * DO_LSE_STRIDE))[(size_t)m * 8 + hd];
            mx = __builtin_fmaxf(ls[0], __builtin_fmaxf(ls[1], ls[2]));
            float w[3], wsum = 0.f;
#pragma unroll
            for (int p = 0; p < 3; ++p) { w[p] = __builtin_amdgcn_exp2f(ls[p] - mx); wsum += w[p]; }
            const float wi = 1.0f / wsum; float acc[8];
#pragma unroll
            for (int j = 0; j < 8; ++j) acc[j] = 0.f;
#pragma unroll
            for (int p = 0; p < 3; ++p) { const u32x4 v = *((const u32x4*)((const bf16_t*)(dout + DO_OPART + (size_t)p * DO_OPART_STRIDE) + (size_t)m * 512) + lane); const float wp = w[p] * wi;
                acc[0] += wp * bf_lo(v.x); acc[1] += wp * bf_hi(v.x); acc[2] += wp * bf_lo(v.y); acc[3] += wp * bf_hi(v.y);
                acc[4] += wp * bf_lo(v.z); acc[5] += wp * bf_hi(v.z); acc[6] += wp * bf_lo(v.w); acc[7] += wp * bf_hi(v.w); }
            float ss = 0.f;
#pragma unroll
            for (int j = 0; j < 8; ++j) ss += acc[j] * acc[j];
            ss = wave_sum(ss);
            const float rinv = 1.0f / __builtin_sqrtf(ss * (1.0f / 512.f) + EPS);
            u32x4 o; o.x = cvtpk(acc[0] * rinv, acc[1] * rinv); o.y = cvtpk(acc[2] * rinv, acc[3] * rinv); o.z = cvtpk(acc[4] * rinv, acc[5] * rinv); o.w = cvtpk(acc[6] * rinv, acc[7] * rinv);
            *((u32x4*)(MIX + (size_t)m * DM + 512) + lane) = o;
        }
    }
    SEAM(3);
    if (IN(4)) {
        pg8::StaticOrder S; pg8::Gemm g{MIX, Wout_t, MTOK, DM, DM, 0}; S.init(MTOK, DM, G, bx);
        pg8::EpiResB<true> E{xp, xs, X1B, part2}; pg8::gemm_phase<pg8::EpiResB<true>, true>(lds, g, S, E);
    }
    SEAM(4);
    if (IN(5)) {
        pg8::StaticOrder S; pg8::Gemm g{X1B, Wup_t, MTOK, FF, DM, 0}; S.init(MTOK, FF, G, bx);
        pg8::EpiUp E{U, part2}; pg8::gemm_phase<pg8::EpiUp, true>(lds, g, S, E);
    }
    SEAM(5);
    if (IN(6)) {
        pg8::StaticOrder S; pg8::Gemm g{U, Wdn_t, MTOK, DM, FF, 0}; S.init(MTOK, DM, G, bx);
        pg8::EpiResB<false> E{xp, xs, X1B, part3}; pg8::gemm_phase<pg8::EpiResB<false>, true>(lds, g, S, E);
    }
    SEAM(6);
    if (IN(7)) {
        const float* gf = a.in[11];
        f32x4 gv[2][2];
#pragma unroll
        for (int j = 0; j < 2; ++j) { gv[j][0] = ((const f32x4*)gf)[2 * (lane + 64 * j)]; gv[j][1] = ((const f32x4*)gf)[2 * (lane + 64 * j) + 1]; }
        for (int m0 = gw; m0 < MTOK; m0 += 2 * NGW) {
            u32x4 xv[2][2]; f32x4 pq[2][4];
#pragma unroll
            for (int q = 0; q < 2; ++q) { const int m = (m0 + q * NGW) < MTOK ? (m0 + q * NGW) : m0;
                const f32x4* pp = (const f32x4*)(part3 + (size_t)m * 16); const u32x4* xr = (const u32x4*)(X1B + (size_t)m * DM);
#pragma unroll
                for (int j = 0; j < 4; ++j) pq[q][j] = pp[j];
#pragma unroll
                for (int j = 0; j < 2; ++j) xv[q][j] = xr[lane + 64 * j]; }
#pragma unroll
            for (int q = 0; q < 2; ++q) { const int m = m0 + q * NGW;
                const f32x4 p0 = pq[q][0], p1 = pq[q][1], p2 = pq[q][2], p3 = pq[q][3];
                const float sum = ((p0[0] + p0[1]) + (p0[2] + p0[3])) + ((p1[0] + p1[1]) + (p1[2] + p1[3])) + ((p2[0] + p2[1]) + (p2[2] + p2[3])) + ((p3[0] + p3[1]) + (p3[2] + p3[3]));
                const float rs = 1.0f / __builtin_sqrtf(sum * (1.0f / DM) + EPS);
                f32x4* orow = (f32x4*)(a.out + (size_t)m * DM);
                if (m < MTOK) {
#pragma unroll
                    for (int j = 0; j < 2; ++j) { const u32x4 w = xv[q][j];
                        orow[2 * (lane + 64 * j)] = (f32x4){bf_lo(w.x), bf_hi(w.x), bf_lo(w.y), bf_hi(w.y)} * rs * gv[j][0];
                        orow[2 * (lane + 64 * j) + 1] = (f32x4){bf_lo(w.z), bf_hi(w.z), bf_lo(w.w), bf_hi(w.w)} * rs * gv[j][1]; } } }
        }
    }
#undef IN
#undef SEAM
}

constexpr int N_PHASES = 8;

extern "C" void kernel_launch(void* const* d_in, const int* in_sizes, int n_in, void* d_out, int out_size, void* d_ws, size_t ws_size, hipStream_t stream) {
    static int grid = 0;
    if (grid == 0) {
        if (n_in != 12 || out_size != MTOK * DM || ws_size < WS_END) { fprintf(stderr, "kernel_launch: unexpected shapes (n_in %d, out %d, ws %zu); nothing launched\n", n_in, out_size, ws_size); grid = -1; return; }
        int dev = 0, cus = 0, per_cu = 0;
        hipGetDevice(&dev); hipDeviceGetAttribute(&cus, hipDeviceAttributeMultiprocessorCount, dev);
        if (hipFuncSetAttribute((const void*)hymba_fwd, hipFuncAttributeMaxDynamicSharedMemorySize, LDS_BYTES) != hipSuccess) { fprintf(stderr, "kernel_launch: hipFuncSetAttribute failed\n"); grid = -1; return; }
        if (hipOccupancyMaxActiveBlocksPerMultiprocessor(&per_cu, (const void*)hymba_fwd, 512, LDS_BYTES) != hipSuccess || per_cu < 1) { fprintf(stderr, "kernel_launch: occupancy query says %d\n", per_cu); per_cu = 1; }
        (void)hipGetLastError();
        grid = cus * 1;
        (void)per_cu;
    }
    if (grid < 0) return;
    Args a{};
    for (int i = 0; i < 12; ++i) a.in[i] = (const float*)d_in[i];
    a.out = (float*)d_out; a.ws = (unsigned char*)d_ws;
#if MK_COOP
    (void)hipMemsetAsync((char*)d_ws + WS_BAR, 0, XCD_BAR_WORDS * 4, stream);
    a.ph_lo = 0; a.ph_hi = N_PHASES;
    void* args[] = {&a};
    hipError_t e = hipLaunchCooperativeKernel((const void*)hymba_fwd, dim3(grid), dim3(512), args, LDS_BYTES, stream);
    if (e != hipSuccess) fprintf(stderr, "cooperative launch failed: %s (grid %d)\n", hipGetErrorString(e), grid);
#else
    for (int p = 0; p < N_PHASES; ++p) { a.ph_lo = p; a.ph_hi = p + 1; hipLaunchKernelGGL(hymba_fwd, dim3(grid), dim3(512), LDS_BYTES, stream, a); }
#endif
}
```
